# Optimizing an MI355X kernel written in HIP

```python
import jax, jax.numpy as jnp
from jax import lax
import numpy as np

D_MODEL = 1024
BATCH = 8
SEQ = 4096
DEPTH = 1

CTX_LEN = 256
GRID_W = 64

GLA_HEADS = 4
GLA_DK = 128
GLA_DV = 256
GLA_KW = GLA_HEADS * GLA_DK
GLA_VW = GLA_HEADS * GLA_DV
GATE_RANK = 16
GATE_NORM = 16.0
CHUNK = 64
ROPE_BASE = 10000.0

POOL_WINDOWS = (2, 4, 8, 16)
POOL_GROUPS = 4
POOL_W = D_MODEL
POOL_GW = POOL_W // POOL_GROUPS

EPS = 1e-6

IN_SPLITS = (GLA_KW, GLA_KW, GLA_VW, GLA_VW, GATE_RANK, GATE_RANK, POOL_W, POOL_W, D_MODEL, D_MODEL)
D_IN = 2 * GLA_KW + 2 * GLA_VW + 2 * GATE_RANK + 2 * POOL_W + 2 * D_MODEL

kernel_name = "hybrid_gla_pool_prefix_dit"


def rmsnorm(x, g):
    xf = x.astype(jnp.float32)
    y = xf * lax.rsqrt(jnp.mean(xf * xf, axis=-1, keepdims=True) + EPS)
    return (y * g.astype(jnp.float32)).astype(x.dtype)


def rope_2d(t, row, col):
    half = GLA_DK // 2
    nf = half // 2
    freqs = ROPE_BASE ** (-jnp.arange(nf, dtype=jnp.float32) / nf)

    def rot(xp, pos):
        ang = pos[:, None] * freqs
        cos = jnp.cos(ang)[None, :, None, :]
        sin = jnp.sin(ang)[None, :, None, :]
        xa, xb = xp[..., :nf], xp[..., nf:]
        return jnp.concatenate([xa * cos - xb * sin, xa * sin + xb * cos], axis=-1)

    return jnp.concatenate([rot(t[..., :half], row), rot(t[..., half:], col)], axis=-1)


def gla_chunked(q, k, v, log_a, s0, with_output):
    B, L, H, DK = q.shape
    n = L // CHUNK

    def to_chunks(t):
        return t.astype(jnp.float32).reshape(B, n, CHUNK, H, t.shape[-1]).transpose(1, 0, 3, 2, 4)

    tri = jnp.tril(jnp.ones((CHUNK, CHUNK), dtype=bool))

    def step(S, inp):
        qc, kc, vc, ac = inp
        b = jnp.cumsum(ac, axis=2)
        bC = b[:, :, -1:, :]
        S_new = jnp.exp(bC[:, :, 0, :, None]) * S + jnp.einsum(
            'bhjd,bhjv->bhdv', kc * jnp.exp(bC - b), vc)
        if not with_output:
            return S_new, None
        diff = b[:, :, :, None, :] - b[:, :, None, :, :]
        decay = jnp.exp(jnp.where(tri[:, :, None], diff, -jnp.inf))
        scores = jnp.einsum('bhid,bhjd,bhijd->bhij', qc, kc, decay)
        o = jnp.einsum('bhij,bhjv->bhiv', scores, vc) + jnp.einsum(
            'bhid,bhdv->bhiv', qc * jnp.exp(b), S)
        return S_new, o

    S, o = lax.scan(step, s0, (to_chunks(q), to_chunks(k), to_chunks(v), to_chunks(log_a)))
    if not with_output:
        return None, S
    o = o.transpose(1, 0, 3, 2, 4).reshape(B, L, H, v.shape[-1])
    return o, S


def gla_bidir(q, k, v, la_f, la_b, s0_f, s0_b, with_output):
    flip = lambda t: t[:, ::-1]
    o_f, s_f = gla_chunked(q, k, v, la_f, s0_f, with_output)
    o_b, s_b = gla_chunked(flip(q), flip(k), flip(v), flip(la_b), s0_b, with_output)
    o = o_f + flip(o_b) if with_output else None
    return o, s_f, s_b


def gla_log_decay(lowrank, w_up, b):
    B, L, _ = lowrank.shape
    gk = (lowrank @ w_up + b).astype(jnp.float32)
    return (jax.nn.log_sigmoid(gk) / GATE_NORM).reshape(B, L, GLA_HEADS, GLA_DK)


def mixer_inputs(h, w_in, w_up_f, b_f, w_up_b, b_b, row, col):
    B, L, _ = h.shape
    p = h @ w_in
    idx = np.cumsum(IN_SPLITS)[:-1].tolist()
    pq, pk, pv, zA, lr_f, lr_b, uB, zB, gA, gB = jnp.split(p, idx, axis=-1)
    q = pq.reshape(B, L, GLA_HEADS, GLA_DK) * (GLA_DK ** -0.5)
    k = pk.reshape(B, L, GLA_HEADS, GLA_DK)
    if row is not None:
        q = rope_2d(q, row, col)
        k = rope_2d(k, row, col)
    v = pv.reshape(B, L, GLA_HEADS, GLA_DV)
    la_f = gla_log_decay(lr_f, w_up_f, b_f)
    la_b = gla_log_decay(lr_b, w_up_b, b_b)
    return q, k, v, la_f, la_b, zA, uB, zB, gA, gB


def multiscale_pool(u, w_pool, pool_scale):
    B, L, _ = u.shape
    uf = u.astype(jnp.float32)
    cs = jnp.concatenate([jnp.zeros_like(uf[:, :1]), jnp.cumsum(uf, axis=1)], axis=1)
    t = jnp.arange(L)
    parts = []
    for g, w in enumerate(POOL_WINDOWS):
        lo = jnp.clip(t - w // 2, 0, L - 1)
        hi = jnp.clip(t + (w - 1 - w // 2), 0, L - 1)
        sl = slice(g * POOL_GW, (g + 1) * POOL_GW)
        csg = cs[..., sl]
        cnt = (hi - lo + 1).astype(jnp.float32)[:, None]
        parts.append((csg[:, hi + 1] - csg[:, lo]) / cnt - uf[..., sl])
    d = jnp.stack(parts, axis=2)
    y = jnp.einsum('blgc,gcd->blgd', d, w_pool.astype(jnp.float32)).reshape(B, L, POOL_W)
    return (y * pool_scale.astype(jnp.float32)).astype(u.dtype)


def branch_out(o, zA, uB, zB, gA, gB, gla_norm_g, w_pool, pool_scale, w_branch_a, w_branch_b, w_out):
    B, L, _ = zA.shape
    o_n = rmsnorm(o, gla_norm_g).astype(zA.dtype).reshape(B, L, GLA_VW)
    yA = (o_n * jax.nn.silu(zA)) @ w_branch_a
    yB = (multiscale_pool(uB, w_pool, pool_scale) * jax.nn.silu(zB)) @ w_branch_b
    merged = jax.nn.sigmoid(gA) * yA + jax.nn.sigmoid(gB) * yB
    return merged @ w_out


def setup_inputs(seed: int = 0) -> dict:
    key = jax.random.key(seed)
    ks = jax.random.split(key, 24)
    f32 = jnp.float32
    nrm = lambda k, s, sc: jax.random.normal(k, s, f32) * sc
    return {
        "x": nrm(ks[0], (BATCH, SEQ, D_MODEL), 1.0),
        "c": nrm(ks[1], (BATCH, D_MODEL), 1.0),
        "ctx": nrm(ks[2], (BATCH, CTX_LEN, D_MODEL), 1.0),
        "c_ctx": nrm(ks[3], (D_MODEL,), 1.0),
        "w_mod": nrm(ks[4], (DEPTH, D_MODEL, 3 * D_MODEL), D_MODEL ** -0.5),
        "b_mod": nrm(ks[5], (DEPTH, 3 * D_MODEL), 0.01),
        "norm_g": 1.0 + nrm(ks[6], (DEPTH, D_MODEL), 0.1),
        "w_in": nrm(ks[7], (DEPTH, D_MODEL, D_IN), D_MODEL ** -0.5),
        "w_gate_up_f": nrm(ks[8], (DEPTH, GATE_RANK, GLA_KW), GATE_RANK ** -0.5),
        "b_gate_f": jax.random.uniform(ks[9], (DEPTH, GLA_KW), f32, 1.0, 5.0),
        "w_gate_up_b": nrm(ks[10], (DEPTH, GATE_RANK, GLA_KW), GATE_RANK ** -0.5),
        "b_gate_b": jax.random.uniform(ks[11], (DEPTH, GLA_KW), f32, 1.0, 5.0),
        "gla_norm_g": 1.0 + nrm(ks[12], (DEPTH, GLA_DV), 0.1),
        "w_pool": nrm(ks[13], (DEPTH, POOL_GROUPS, POOL_GW, POOL_GW), POOL_GW ** -0.5),
        "pool_scale": 1.0 + nrm(ks[14], (DEPTH, POOL_W), 0.1),
        "w_branch_a": nrm(ks[15], (DEPTH, GLA_VW, D_MODEL), GLA_VW ** -0.5),
        "w_branch_b": nrm(ks[16], (DEPTH, POOL_W, D_MODEL), POOL_W ** -0.5),
        "w_out": nrm(ks[17], (DEPTH, D_MODEL, D_MODEL), D_MODEL ** -0.5),
        "final_norm_g": 1.0 + nrm(ks[18], (D_MODEL,), 0.1),
    }


def reference(x, c, ctx, c_ctx, w_mod, b_mod, norm_g, w_in, w_gate_up_f, b_gate_f,
              w_gate_up_b, b_gate_b, gla_norm_g, w_pool, pool_scale, w_branch_a,
              w_branch_b, w_out, final_norm_g):
    B, L, _ = x.shape
    ROWS = L // GRID_W
    t = jnp.arange(ROWS * GRID_W)
    row = (t // GRID_W).astype(jnp.float32)
    col = (t % GRID_W).astype(jnp.float32)

    for l in range(DEPTH):
        last = l == DEPTH - 1
        shift_x, scale_x, gate_x = jnp.split(jax.nn.silu(c) @ w_mod[l] + b_mod[l], 3, axis=-1)
        shift_x, scale_x, gate_x = shift_x[:, None], scale_x[:, None], gate_x[:, None]
        shift_c, scale_c, gate_c = jnp.split(jax.nn.silu(c_ctx) @ w_mod[l] + b_mod[l], 3, axis=-1)

        hc = rmsnorm(ctx, norm_g[l]) * (1.0 + scale_c) + shift_c
        qc, kc, vc, laf_c, lab_c, zAc, uBc, zBc, gAc, gBc = mixer_inputs(
            hc, w_in[l], w_gate_up_f[l], b_gate_f[l], w_gate_up_b[l], b_gate_b[l], None, None)
        s_zero = jnp.zeros((B, GLA_HEADS, GLA_DK, GLA_DV), jnp.float32)
        oc, s_f, s_b = gla_bidir(qc, kc, vc, laf_c, lab_c, s_zero, s_zero, not last)

        hx = rmsnorm(x, norm_g[l]) * (1.0 + scale_x) + shift_x
        q, k, v, la_f, la_b, zA, uB, zB, gA, gB = mixer_inputs(
            hx, w_in[l], w_gate_up_f[l], b_gate_f[l], w_gate_up_b[l], b_gate_b[l], row, col)
        ox, _, _ = gla_bidir(q, k, v, la_f, la_b, s_f, s_b, True)
        y = branch_out(ox.astype(x.dtype), zA, uB, zB, gA, gB, gla_norm_g[l], w_pool[l],
                       pool_scale[l], w_branch_a[l], w_branch_b[l], w_out[l])
        x_new = x + gate_x * y

        if not last:
            yc = branch_out(oc.astype(ctx.dtype), zAc, uBc, zBc, gAc, gBc, gla_norm_g[l], w_pool[l],
                            pool_scale[l], w_branch_a[l], w_branch_b[l], w_out[l])
            ctx = ctx + gate_c * yc
        x = x_new

    return rmsnorm(x, final_norm_g)
```

```cpp
#include <hip/hip_runtime.h>
#include <cstdio>
#include <cstdint>
namespace pg8 {
#define PG8_LAS __attribute__((address_space(3)))
typedef unsigned short bf16_t;
typedef short bf16x8 __attribute__((ext_vector_type(8)));
typedef float f32x4 __attribute__((ext_vector_type(4)));
typedef unsigned u32x4 __attribute__((ext_vector_type(4)));
constexpr int BM = 256, BK = 64, HALF = 128, HTB = HALF * BK * 2  , STAGE_BYTES = 8 * HTB, NXCD = 8, WGM = 8;

__host__ __device__ __forceinline__ int lds_byte(int r, int c) { const int st = (r >> 4) * 2 + (c >> 5), rr = r & 15, cc = c & 31, ob = rr * 64 + cc * 2; return st * 1024 + (ob ^ (((ob >> 9) & 1) << 5)); }
__host__ __device__ __forceinline__ void stage_rc(int b, int& R, int& C) { const int st = b / 1024, sb = b % 1024, swz = sb ^ (((sb >> 9) & 1) << 5); R = (st >> 1) * 16 + swz / 64; C = (st & 1) * 32 + (swz % 64) / 2; }
__host__ __device__ __forceinline__ int perm32(int rho) { const int n = rho >> 4, i = rho & 15; return 8 * (i >> 2) + 4 * n + (i & 3); }

__device__ __forceinline__ unsigned cvt_pk_bf16(float lo, float hi) { unsigned r; asm volatile("v_cvt_pk_bf16_f32 %0, %1, %2" : "=v"(r) : "v"(lo), "v"(hi)); return r; }
struct Unit { int pm, pn; };
struct Gemm { const bf16_t* A; const bf16_t* Bt; int K, lda, acol; };

struct StaticOrder {
    int nM, nN, nwg, G, c;
    __host__ __device__ void init(int M, int N, int G_, int c_) { nM = M / BM; nN = N / BM; nwg = nM * nN; G = G_; c = c_; }
    __host__ __device__ bool next(int i, Unit& u) const {
        const long L = (long)i * G + c; if (L >= nwg) return false;
        int wgid = (int)L; { const int q = nwg / NXCD, r = nwg % NXCD, xcd = wgid % NXCD, off = wgid / NXCD; wgid = (xcd < r ? xcd * (q + 1) : r * (q + 1) + (xcd - r) * q) + off; }
        const int nig = WGM * nN, gid = wgid / nig, fm = gid * WGM, gsz = (nM - fm) < WGM ? (nM - fm) : WGM;
        u.pm = fm + ((wgid % nig) % gsz); u.pn = (wgid % nig) / gsz; return true;
    }
    __device__ __forceinline__ void a_ready(const Unit&) const {}
    __device__ __forceinline__ void done(const Unit&) const {}
};

template <class Epi, class Sched, bool ALIGN_EPI = false, bool SP2 = false>
__device__ __forceinline__ void gemm_phase(PG8_LAS unsigned char* lds, const Gemm g, const Sched& S, const Epi& E) {
    const int tid = threadIdx.x, wid = __builtin_amdgcn_readfirstlane(tid >> 6), lane = tid & 63, wr = wid >> 2, wc = wid & 3, fr = lane & 15, fq = lane >> 4;
    int K_ = g.K; asm volatile("" : "+s"(K_));
    const int K = K_, nt = K / BK;
    unsigned voffA[2], voffB[2];
#pragma unroll
    for (int i = 0; i < 2; ++i) { int R, C; stage_rc(tid * 16 + i * 8192, R, C); const int Rb = Epi::PERM ? ((R & ~31) + perm32(R & 31)) : R;
        voffA[i] = (unsigned)(R * g.lda + C) * 2u; voffB[i] = (unsigned)(Rb * K + C) * 2u; }
    const size_t kstep = (size_t)(BK * 2);
    const size_t hstepA = (size_t)HALF * g.lda * 2, hstepB = (size_t)HALF * K * 2;
    const size_t tstepA = 2 * hstepA, tstepB = 2 * hstepB;
    const unsigned ldsw = (unsigned)wid * 1024u;
    const int aoff = lds_byte(wr * 64 + fr, fq * 8), boff = lds_byte(wc * 32 + fr, fq * 8);
#define PG8_SA(b, h) (((b) * 2 + (h)) * HTB)
#define PG8_SB(b, h) ((4 + (b) * 2 + (h)) * HTB)
#define PG8_STAGE(bufoff, gbase, voff) do { _Pragma("unroll") for (int _i = 0; _i < 2; ++_i) \
        __builtin_amdgcn_global_load_lds((const unsigned*)((const char*)(gbase) + (voff)[_i]), (PG8_LAS unsigned*)(lds + (bufoff) + ldsw + _i * 8192), 16, 0, 0); } while (0)
#define PG8_LDA(dst, b, h) do { _Pragma("unroll") for (int m = 0; m < 4; ++m) _Pragma("unroll") for (int k = 0; k < 2; ++k) dst[m][k] = *(const PG8_LAS bf16x8*)(lds + PG8_SA(b, h) + aoff + m * 2048 + k * 1024); } while (0)
#define PG8_LDB(dst, b, h) do { _Pragma("unroll") for (int n = 0; n < 2; ++n) _Pragma("unroll") for (int k = 0; k < 2; ++k) dst[n][k] = *(const PG8_LAS bf16x8*)(lds + PG8_SB(b, h) + boff + n * 2048 + k * 1024); } while (0)
#define PG8_MMA(ai, bj, At, Bt) do { __builtin_amdgcn_s_setprio(1); _Pragma("unroll") for (int m = 0; m < 4; ++m) _Pragma("unroll") for (int n = 0; n < 2; ++n) _Pragma("unroll") for (int k = 0; k < 2; ++k) \
        acc[ai][bj][m][n] = __builtin_amdgcn_mfma_f32_16x16x32_bf16(Bt[n][k], At[m][k], acc[ai][bj][m][n], 0, 0, 0); __builtin_amdgcn_s_setprio(0); } while (0)
#define PG8_WAIT_V(n) asm volatile("s_waitcnt vmcnt(" #n ")" ::: "memory")
#define PG8_WAIT_L(n) asm volatile("s_waitcnt lgkmcnt(" #n ")" ::: "memory")
#define PG8_BAR __builtin_amdgcn_s_barrier()
#define PG8_SCHED __builtin_amdgcn_sched_barrier(0)
    Unit cur, nxt; int ui = 0;
    if (!S.next(0, cur)) return;
    f32x4 acc[2][2][4][2];
#pragma unroll
    for (int a = 0; a < 2; ++a)
#pragma unroll
        for (int b = 0; b < 2; ++b)
#pragma unroll
            for (int m = 0; m < 4; ++m)
#pragma unroll
                for (int n = 0; n < 2; ++n) acc[a][b][m][n] = (f32x4){0.f, 0.f, 0.f, 0.f};
    bf16x8 At[4][2], B0[2][2], B1[2][2];
    const char* cA = (const char*)g.A + (size_t)cur.pm * tstepA + (size_t)cur.pn * (size_t)g.acol * 2; const char* cB = (const char*)g.Bt + (size_t)cur.pn * tstepB;
    S.a_ready(cur);
    if constexpr (SP2) {
        PG8_STAGE(PG8_SB(0, 0), cB, voffB); PG8_STAGE(PG8_SB(0, 1), cB + hstepB, voffB); PG8_STAGE(PG8_SA(0, 0), cA, voffA); PG8_STAGE(PG8_SA(0, 1), cA + hstepA, voffA);
        if (wr == 1) PG8_BAR;
        PG8_WAIT_V(2); PG8_BAR;
        PG8_STAGE(PG8_SB(1, 0), cB + kstep, voffB); PG8_STAGE(PG8_SA(1, 0), cA + kstep, voffA); PG8_STAGE(PG8_SB(1, 1), cB + hstepB + kstep, voffB);
        PG8_WAIT_V(6); PG8_BAR;
    } else {
        PG8_STAGE(PG8_SB(0, 0), cB, voffB); PG8_STAGE(PG8_SA(0, 0), cA, voffA); PG8_STAGE(PG8_SB(0, 1), cB + hstepB, voffB); PG8_STAGE(PG8_SA(0, 1), cA + hstepA, voffA);
        if (wr == 1) PG8_BAR;
        PG8_WAIT_V(4); PG8_BAR;
        PG8_STAGE(PG8_SB(1, 0), cB + kstep, voffB); PG8_STAGE(PG8_SA(1, 0), cA + kstep, voffA); PG8_STAGE(PG8_SB(1, 1), cB + hstepB + kstep, voffB);
        PG8_WAIT_V(6); PG8_BAR;
    }
    for (;;) {
        const bool has_next = S.next(ui + 1, nxt);
        const char* nA = has_next ? (const char*)g.A + (size_t)nxt.pm * tstepA + (size_t)nxt.pn * (size_t)g.acol * 2 : cA; const char* nB = has_next ? (const char*)g.Bt + (size_t)nxt.pn * tstepB : cB;
        for (int t = 0; t < nt; t += 2) {
            const bool last = (t == nt - 2);
            const char* a1 = cA + (size_t)(t + 1) * kstep;
            const char* a2 = last ? nA : cA + (size_t)(t + 2) * kstep; const char* b2 = last ? nB : cB + (size_t)(t + 2) * kstep;
            const char* a3 = a2 + kstep; const char* b3 = b2 + kstep;
            if (last && has_next) S.a_ready(nxt);
            if constexpr (SP2) {
            PG8_LDB(B0, 0, 0); PG8_LDB(B1, 0, 1); PG8_SCHED; PG8_LDA(At, 0, 0); PG8_STAGE(PG8_SA(1, 1), a1 + hstepA, voffA);
            PG8_WAIT_V(8); PG8_WAIT_L(0); PG8_BAR; PG8_MMA(0, 0, At, B0); PG8_MMA(0, 1, At, B1); PG8_BAR; PG8_SCHED;
            PG8_LDA(At, 0, 1); PG8_STAGE(PG8_SB(0, 0), b2, voffB); PG8_STAGE(PG8_SB(0, 1), b2 + hstepB, voffB); PG8_STAGE(PG8_SA(0, 0), a2, voffA);
            PG8_WAIT_V(8); PG8_WAIT_L(0); PG8_BAR; PG8_MMA(1, 0, At, B0); PG8_MMA(1, 1, At, B1); PG8_BAR; PG8_SCHED;
            PG8_LDB(B0, 1, 0); PG8_LDB(B1, 1, 1); PG8_SCHED; PG8_LDA(At, 1, 0); PG8_STAGE(PG8_SA(0, 1), a2 + hstepA, voffA);
            PG8_WAIT_V(8); PG8_WAIT_L(0); PG8_BAR; PG8_MMA(0, 0, At, B0); PG8_MMA(0, 1, At, B1); PG8_BAR; PG8_SCHED;
            PG8_LDA(At, 1, 1); PG8_STAGE(PG8_SB(1, 0), b3, voffB); PG8_STAGE(PG8_SB(1, 1), b3 + hstepB, voffB); PG8_STAGE(PG8_SA(1, 0), a3, voffA);
            PG8_WAIT_V(8); PG8_WAIT_L(0); PG8_BAR; PG8_MMA(1, 0, At, B0); PG8_MMA(1, 1, At, B1); PG8_BAR; PG8_SCHED;
            } else {
            PG8_LDB(B0, 0, 0); PG8_SCHED; PG8_LDA(At, 0, 0); PG8_STAGE(PG8_SA(1, 1), a1 + hstepA, voffA);
            PG8_WAIT_L(8); PG8_BAR; PG8_WAIT_L(0); PG8_MMA(0, 0, At, B0); PG8_BAR; PG8_SCHED;
            PG8_LDB(B1, 0, 1); PG8_STAGE(PG8_SB(0, 0), b2, voffB);
            PG8_BAR; PG8_WAIT_L(0); PG8_MMA(0, 1, At, B1); PG8_BAR;
            PG8_LDA(At, 0, 1); PG8_STAGE(PG8_SA(0, 0), a2, voffA);
            PG8_BAR; PG8_WAIT_L(0); PG8_MMA(1, 0, At, B0); PG8_BAR; PG8_SCHED;
            PG8_STAGE(PG8_SB(0, 1), b2 + hstepB, voffB);
            PG8_WAIT_V(6); PG8_BAR; PG8_MMA(1, 1, At, B1); PG8_BAR;
            PG8_LDB(B0, 1, 0); PG8_SCHED; PG8_LDA(At, 1, 0); PG8_STAGE(PG8_SA(0, 1), a2 + hstepA, voffA);
            PG8_WAIT_L(8); PG8_BAR; PG8_WAIT_L(0); PG8_MMA(0, 0, At, B0); PG8_BAR; PG8_SCHED;
            PG8_LDB(B1, 1, 1); PG8_STAGE(PG8_SB(1, 0), b3, voffB);
            PG8_BAR; PG8_WAIT_L(0); PG8_MMA(0, 1, At, B1); PG8_BAR;
            PG8_LDA(At, 1, 1); PG8_STAGE(PG8_SA(1, 0), a3, voffA);
            PG8_BAR; PG8_WAIT_L(0); PG8_MMA(1, 0, At, B0); PG8_BAR; PG8_SCHED;
            PG8_STAGE(PG8_SB(1, 1), b3 + hstepB, voffB);
            PG8_WAIT_V(6); PG8_BAR; PG8_MMA(1, 1, At, B1); PG8_BAR;
            }
        }
        if constexpr (ALIGN_EPI) { if (wr == 0) PG8_BAR; }
        if constexpr (!Epi::AFTER_DRAIN) { E(acc, cur, wr, wc, fr, fq); S.done(cur); }
        if (!has_next) break;
#pragma unroll
        for (int a = 0; a < 2; ++a)
#pragma unroll
            for (int b = 0; b < 2; ++b)
#pragma unroll
                for (int m = 0; m < 4; ++m)
#pragma unroll
                    for (int n = 0; n < 2; ++n) acc[a][b][m][n] = (f32x4){0.f, 0.f, 0.f, 0.f};
        cur = nxt; cA = nA; cB = nB; ++ui;
        if constexpr (ALIGN_EPI) { if (wr == 1) PG8_BAR; }
    }
    PG8_WAIT_V(0);
    if constexpr (!ALIGN_EPI) { if (wr == 0) PG8_BAR; }
    PG8_BAR;
    if constexpr (Epi::AFTER_DRAIN) { E.fused(acc, cur, wr, wc, fr, fq, lds, wid, lane); S.done(cur); }
#undef PG8_SA
#undef PG8_SB
#undef PG8_STAGE
#undef PG8_LDA
#undef PG8_LDB
#undef PG8_MMA
#undef PG8_WAIT_V
#undef PG8_WAIT_L
#undef PG8_BAR
#undef PG8_SCHED
}
}


#define GAS __attribute__((address_space(1)))
#define LAS __attribute__((address_space(3)))
typedef unsigned short bf16;
typedef unsigned v4u __attribute__((ext_vector_type(4)));
typedef float f32x4 __attribute__((ext_vector_type(4)));
typedef short bf16x8 __attribute__((ext_vector_type(8)));
typedef GAS unsigned gu32;
typedef GAS unsigned long long gu64;
#define RLX_AGENT __ATOMIC_RELAXED, __HIP_MEMORY_SCOPE_AGENT
#define LDS_WAIT() asm volatile("s_waitcnt lgkmcnt(0)" ::: "memory")
#define VM_WAIT() asm volatile("s_waitcnt vmcnt(0)" ::: "memory")
__device__ __forceinline__ unsigned long long rt() { return __builtin_amdgcn_s_memrealtime(); }
__device__ __forceinline__ unsigned f2bf(float f) { unsigned u = __builtin_bit_cast(unsigned, f); return (u + 0x7fffu + ((u >> 16) & 1u)) >> 16; }
__device__ __forceinline__ unsigned pk2(float lo, float hi) { return f2bf(lo) | (f2bf(hi) << 16); }

#define XB_TMO      128
#define XB_XCNT(j)  (256  + 64 * (j))
#define XB_XSUB(j)  (1280 + 64 * (j))
#define XB_XGEN(j)  (2304 + 64 * (j))
#define XB_TOP      3328
#define XB_TOPGEN   3392
#define XCD_BAR_WORDS 3456
#define XB_SPIN_CAP (1u << 18)

__device__ __forceinline__ unsigned xb_ld(unsigned* p)              { return __hip_atomic_load(p, __ATOMIC_RELAXED, __HIP_MEMORY_SCOPE_AGENT); }
__device__ __forceinline__ unsigned xb_add(unsigned* p, unsigned v) { return __hip_atomic_fetch_add(p, v, __ATOMIC_RELAXED, __HIP_MEMORY_SCOPE_AGENT); }
__device__ __forceinline__ unsigned xb_xcc_id() { return (unsigned)__builtin_amdgcn_s_getreg((3 << 11) | 20) & 0xFu; }
#define XB_SPIN(cond, bar) do { unsigned _sp = 0; while (cond) { __builtin_amdgcn_s_sleep(1); \
    if ((++_sp & 255u) == 0u) { if (xb_ld(&(bar)[XB_TMO])) break; if (_sp > XB_SPIN_CAP) { atomicAdd(&(bar)[XB_TMO], 1u); break; } } } } while (0)

struct XcdBarrier {
    unsigned* bar; unsigned x;
    volatile LAS unsigned* st;
};

__device__ __forceinline__ XcdBarrier xcd_barrier_post(unsigned* bar, volatile LAS unsigned* st) {
    XcdBarrier b; b.bar = bar; b.x = xb_xcc_id(); b.st = st;
    if (threadIdx.x == 0) (void)xb_add(&bar[XB_XCNT(b.x)], 1u);
    return b;
}
__device__ __forceinline__ void xcd_barrier_complete(unsigned* bar, unsigned x, unsigned& nloc, unsigned& nx) {
    const unsigned G = gridDim.x * gridDim.y * gridDim.z;
    unsigned sum, cnt, mine, sp = 0u;
    for (;;) {
        sum = 0u; cnt = 0u; mine = 0u;
#pragma unroll
        for (unsigned j = 0; j < 16; ++j) { const unsigned c = xb_ld(&bar[XB_XCNT(j)]); sum += c; cnt += (c > 0u) ? 1u : 0u; mine = (j == x) ? c : mine; }
        if (sum == G) break;
        __builtin_amdgcn_s_sleep(1);
        if ((++sp & 255u) == 0u) { if (xb_ld(&bar[XB_TMO])) break; if (sp > XB_SPIN_CAP) { atomicAdd(&bar[XB_TMO], 1u); break; } }
    }
    nloc = mine > 0u ? mine : 1u; nx = cnt > 0u ? cnt : 1u;
}

__device__ __forceinline__ void xcd_barrier(const XcdBarrier& b) {
    asm volatile("s_waitcnt vmcnt(0)" ::: "memory");
    __syncthreads();
    if (threadIdx.x == 0) {
        unsigned* bar = b.bar;
        __builtin_amdgcn_s_waitcnt(0);
        unsigned nloc = b.st[0], nx = b.st[1];
        if (nloc == 0u) { xcd_barrier_complete(bar, b.x, nloc, nx); b.st[0] = nloc; b.st[1] = nx; }
        const unsigned old = xb_add(&bar[XB_XSUB(b.x)], 1u);
        const unsigned gen = old / nloc;
        if (old + 1u == (gen + 1u) * nloc) {
            __builtin_amdgcn_fence(__ATOMIC_RELEASE, "agent");
            asm volatile("s_waitcnt vmcnt(0)" ::: "memory");
            const unsigned og = xb_add(&bar[XB_TOP], 1u);
            const unsigned tg = og / nx;
            if (og + 1u == (tg + 1u) * nx) xb_add(&bar[XB_TOPGEN], 1u);
            else XB_SPIN(xb_ld(&bar[XB_TOPGEN]) == tg, bar);
            __builtin_amdgcn_fence(__ATOMIC_ACQUIRE, "agent");
            xb_add(&bar[XB_XGEN(b.x)], 1u);
            asm volatile("s_waitcnt vmcnt(0)" ::: "memory");
        } else {
            XB_SPIN(xb_ld(&bar[XB_XGEN(b.x)]) == gen, bar);
            __builtin_amdgcn_fence(__ATOMIC_ACQUIRE, "agent");
            asm volatile("s_waitcnt vmcnt(0)" ::: "memory");
        }
    }
    __syncthreads();
}


constexpr int DM = 1024, NB = 8, SEQ = 4096, CTXL = 256;
constexpr int MX = NB * SEQ, MC = NB * CTXL, MT = MX + MC;
constexpr int DIN = 7200, N1 = 7424, N1A = 2304;
constexpr float EPS = 1e-6f;
constexpr int NWAVES = 8;

constexpr size_t MiB = 1u << 20;
constexpr size_t WS_CTL = 0, CTL_ZERO_BYTES = 1 * MiB;
constexpr size_t WS_MOD = 1 * MiB;
constexpr size_t WS_ROPE = 1 * MiB + 128 * 1024;
constexpr size_t WS_RSTD = 1 * MiB + 256 * 1024;
constexpr size_t WS_SS = 2 * MiB;
constexpr size_t WS_LR = 4 * MiB;
constexpr size_t WS_W1T = 10 * MiB;
constexpr size_t WS_WAT = 25 * MiB, WS_WBT = 27 * MiB, WS_WOT = 29 * MiB, WS_WPT = 31 * MiB;
constexpr size_t WS_Q = 32 * MiB;
constexpr size_t WS_K = 64 * MiB;
constexpr size_t WS_V = 98 * MiB;
constexpr size_t WS_OF = 166 * MiB, WS_OB = 230 * MiB;
constexpr size_t WS_A1 = 294 * MiB, WS_UB = 358 * MiB, WS_ZB = 422 * MiB;
constexpr size_t WS_GA = 32 * MiB, WS_GB = 96 * MiB;
constexpr size_t WS_D = WS_OF;
constexpr size_t WS_END = 486 * MiB;
constexpr int CW_BAR = 4096;

constexpr int RING_BYTES = 131072;
constexpr int LDSCTL_OFF = RING_BYTES, MISC_OFF = LDSCTL_OFF + 320;
constexpr int LDS_BYTES = 147456;

typedef unsigned v2u __attribute__((ext_vector_type(2)));
__device__ __forceinline__ float bf2f(unsigned short u) { return __builtin_bit_cast(float, (unsigned)u << 16); }
__device__ __forceinline__ float bflo(unsigned w) { return __builtin_bit_cast(float, w << 16); }
__device__ __forceinline__ float bfhi(unsigned w) { return __builtin_bit_cast(float, w & 0xffff0000u); }
typedef float f32x2_t __attribute__((ext_vector_type(2))); typedef __bf16 bf16x2_t __attribute__((ext_vector_type(2)));
__device__ __forceinline__ unsigned cvtpk(float lo, float hi) { f32x2_t v = {lo, hi}; bf16x2_t b = __builtin_convertvector(v, bf16x2_t); return __builtin_bit_cast(unsigned, b); }
__device__ __forceinline__ float fast_sigmoid(float x) { return __builtin_amdgcn_rcpf(1.0f + __expf(-x)); }
__device__ __forceinline__ float fast_silu(float x) { return x * fast_sigmoid(x); }
__device__ __forceinline__ float wave_sum(float v) {
#pragma unroll
    for (int o = 1; o < 64; o <<= 1) v += __shfl_xor(v, o);
    return v;
}

struct OrderG1A {
    pg8::StaticOrder so; int G, c;
    __device__ void init(int G_, int c_) { so.init(MX, N1A, G_, c_); G = G_; c = c_; }
    __device__ bool next(int i, pg8::Unit& u) const {
        const int L = i * G + c;
        if (L < so.nwg) return so.next(i, u);
        const int e = L - so.nwg; if (e >= 56) return false;
        u.pm = 128 + e / 7; u.pn = 2 + e % 7; return true;
    }
    __device__ __forceinline__ void a_ready(const pg8::Unit&) const {}
    __device__ __forceinline__ void done(const pg8::Unit&) const {}
};

using pg8::Unit;
#define EPI_ROWS(...) _Pragma("unroll") for (int ai = 0; ai < 2; ++ai) _Pragma("unroll") for (int m = 0; m < 4; ++m) { const int row = row0 + ai * 128 + m * 16; __VA_ARGS__ }

struct EpiQKV {
    static constexpr bool PERM = true, AFTER_DRAIN = false;
    bf16 *Q, *K, *V; float* LR; const float* rope;
    __device__ __forceinline__ void operator()(const f32x4 (&acc)[2][2][4][2], const Unit& u, int wr, int wc, int fr, int fq) const {
        const int pn = u.pn, row0 = u.pm * 256 + wr * 64 + fr, lc0 = wc * 32 + 8 * fq;
        if (pn < 4) {
            const bool isq = pn < 2; const float sc = isq ? 0.08838834764831845f : 1.0f;
            bf16* base = isq ? Q : K; const int colt = (pn & 1) * 256;
            const int jj0 = wc * 16 + 4 * fq, jf = jj0 & 31; const bool colpart = jj0 >= 32;
            EPI_ROWS(
                f32x4 cs0 = (f32x4){1.f, 0.f, 1.f, 0.f}, cs1 = cs0;
                if (row < MX) { const int s = row & 4095, pos = colpart ? (s & 63) : (s >> 6); const f32x4* rp = (const f32x4*)(rope + (pos * 32 + jf) * 2); cs0 = rp[0]; cs1 = rp[1]; }
                _Pragma("unroll") for (int bj = 0; bj < 2; ++bj) {
                    const f32x4 v0 = acc[ai][bj][m][0] * sc, v1 = acc[ai][bj][m][1] * sc;
                    v4u w;
                    w.x = cvtpk(v0[0] * cs0[0] - v0[1] * cs0[1], v0[0] * cs0[1] + v0[1] * cs0[0]);
                    w.y = cvtpk(v0[2] * cs0[2] - v0[3] * cs0[3], v0[2] * cs0[3] + v0[3] * cs0[2]);
                    w.z = cvtpk(v1[0] * cs1[0] - v1[1] * cs1[1], v1[0] * cs1[1] + v1[1] * cs1[0]);
                    w.w = cvtpk(v1[2] * cs1[2] - v1[3] * cs1[3], v1[2] * cs1[3] + v1[3] * cs1[2]);
                    *(v4u*)(base + (size_t)row * 512 + colt + bj * 128 + lc0) = w;
                }
            )
        } else if (pn < 8) {
            const int colt = (pn - 4) * 256;
            EPI_ROWS(
                _Pragma("unroll") for (int bj = 0; bj < 2; ++bj) {
                    const f32x4 v0 = acc[ai][bj][m][0], v1 = acc[ai][bj][m][1];
                    v4u w; w.x = cvtpk(v0[0], v0[1]); w.y = cvtpk(v0[2], v0[3]); w.z = cvtpk(v1[0], v1[1]); w.w = cvtpk(v1[2], v1[3]);
                    *(v4u*)(V + (size_t)row * 1024 + colt + bj * 128 + lc0) = w;
                }
            )
        } else {
            if (wc == 0) {
                EPI_ROWS(
                    *(f32x4*)(LR + (size_t)row * 32 + 8 * fq) = acc[ai][0][m][0];
                    *(f32x4*)(LR + (size_t)row * 32 + 8 * fq + 4) = acc[ai][0][m][1];
                )
            }
        }
    }
};

struct EpiB {
    static constexpr bool PERM = true, AFTER_DRAIN = false;
    bf16 *A1, *UB, *ZB, *GA, *GB; const bf16 *OF, *OB; const float *rstd, *gn;
    __device__ __forceinline__ void operator()(const f32x4 (&acc)[2][2][4][2], const Unit& u, int wr, int wc, int fr, int fq) const {
        const int type = u.pn >> 2, cq = u.pn & 3, row0 = u.pm * 256 + wr * 64 + fr, col0 = cq * 256 + wc * 32 + 8 * fq;
        if (type == 0) {
            f32x4 g0[2], g1[2];
#pragma unroll
            for (int bj = 0; bj < 2; ++bj) { g0[bj] = *(const f32x4*)(gn + bj * 128 + wc * 32 + 8 * fq); g1[bj] = *(const f32x4*)(gn + bj * 128 + wc * 32 + 8 * fq + 4); }
            EPI_ROWS(
                const float r = rstd[(size_t)row * 4 + cq];
                _Pragma("unroll") for (int bj = 0; bj < 2; ++bj) {
                    const size_t off = (size_t)row * 1024 + col0 + bj * 128;
                    const v4u of = *(const v4u*)(OF + off), ob = *(const v4u*)(OB + off);
                    const f32x4 v0 = acc[ai][bj][m][0], v1 = acc[ai][bj][m][1];
                    float o[8];
                    o[0] = bflo(of.x) + bflo(ob.x); o[1] = bfhi(of.x) + bfhi(ob.x); o[2] = bflo(of.y) + bflo(ob.y); o[3] = bfhi(of.y) + bfhi(ob.y);
                    o[4] = bflo(of.z) + bflo(ob.z); o[5] = bfhi(of.z) + bfhi(ob.z); o[6] = bflo(of.w) + bflo(ob.w); o[7] = bfhi(of.w) + bfhi(ob.w);
                    v4u w;
                    w.x = cvtpk(o[0] * r * g0[bj][0] * fast_silu(v0[0]), o[1] * r * g0[bj][1] * fast_silu(v0[1]));
                    w.y = cvtpk(o[2] * r * g0[bj][2] * fast_silu(v0[2]), o[3] * r * g0[bj][3] * fast_silu(v0[3]));
                    w.z = cvtpk(o[4] * r * g1[bj][0] * fast_silu(v1[0]), o[5] * r * g1[bj][1] * fast_silu(v1[1]));
                    w.w = cvtpk(o[6] * r * g1[bj][2] * fast_silu(v1[2]), o[7] * r * g1[bj][3] * fast_silu(v1[3]));
                    *(v4u*)(A1 + off) = w;
                }
            )
        } else if (type == 1) {
            EPI_ROWS(
                _Pragma("unroll") for (int bj = 0; bj < 2; ++bj) {
                    const f32x4 v0 = acc[ai][bj][m][0], v1 = acc[ai][bj][m][1];
                    v4u w; w.x = cvtpk(v0[0], v0[1]); w.y = cvtpk(v0[2], v0[3]); w.z = cvtpk(v1[0], v1[1]); w.w = cvtpk(v1[2], v1[3]);
                    *(v4u*)(UB + (size_t)row * 1024 + col0 + bj * 128) = w;
                }
            )
        } else if (type == 2) {
            EPI_ROWS(
                _Pragma("unroll") for (int bj = 0; bj < 2; ++bj) {
                    const f32x4 v0 = acc[ai][bj][m][0], v1 = acc[ai][bj][m][1];
                    v4u w; w.x = cvtpk(fast_silu(v0[0]), fast_silu(v0[1])); w.y = cvtpk(fast_silu(v0[2]), fast_silu(v0[3])); w.z = cvtpk(fast_silu(v1[0]), fast_silu(v1[1])); w.w = cvtpk(fast_silu(v1[2]), fast_silu(v1[3]));
                    *(v4u*)(ZB + (size_t)row * 1024 + col0 + bj * 128) = w;
                }
            )
        } else {
            bf16* dst = type == 3 ? GA : GB;
            EPI_ROWS(
                _Pragma("unroll") for (int bj = 0; bj < 2; ++bj) {
                    const f32x4 v0 = acc[ai][bj][m][0], v1 = acc[ai][bj][m][1];
                    v4u w; w.x = cvtpk(fast_sigmoid(v0[0]), fast_sigmoid(v0[1])); w.y = cvtpk(fast_sigmoid(v0[2]), fast_sigmoid(v0[3])); w.z = cvtpk(fast_sigmoid(v1[0]), fast_sigmoid(v1[1])); w.w = cvtpk(fast_sigmoid(v1[2]), fast_sigmoid(v1[3]));
                    *(v4u*)(dst + (size_t)row * 1024 + col0 + bj * 128) = w;
                }
            )
        }
    }
};

template <int MODE> struct EpiMul {
    static constexpr bool PERM = true, AFTER_DRAIN = false;
    bf16* T; const bf16* U; const float* vec;
    __device__ __forceinline__ void operator()(const f32x4 (&acc)[2][2][4][2], const Unit& u, int wr, int wc, int fr, int fq) const {
        const int row0 = u.pm * 256 + wr * 64 + fr, col0 = u.pn * 256 + wc * 32 + 8 * fq;
        f32x4 s0[2], s1[2];
#pragma unroll
        for (int bj = 0; bj < 2; ++bj) { s0[bj] = (f32x4){1.f, 1.f, 1.f, 1.f}; s1[bj] = s0[bj]; if (MODE == 0) { s0[bj] = *(const f32x4*)(vec + col0 + bj * 128); s1[bj] = *(const f32x4*)(vec + col0 + bj * 128 + 4); } }
        EPI_ROWS(
            _Pragma("unroll") for (int bj = 0; bj < 2; ++bj) {
                const size_t off = (size_t)row * 1024 + col0 + bj * 128;
                const v4u t = *(const v4u*)(T + off);
                const f32x4 v0 = acc[ai][bj][m][0] * s0[bj], v1 = acc[ai][bj][m][1] * s1[bj];
                float o[8];
                o[0] = v0[0] * bflo(t.x); o[1] = v0[1] * bfhi(t.x); o[2] = v0[2] * bflo(t.y); o[3] = v0[3] * bfhi(t.y);
                o[4] = v1[0] * bflo(t.z); o[5] = v1[1] * bfhi(t.z); o[6] = v1[2] * bflo(t.w); o[7] = v1[3] * bfhi(t.w);
                if (MODE == 2) { const v4u y = *(const v4u*)(U + off);
                    o[0] += bflo(y.x); o[1] += bfhi(y.x); o[2] += bflo(y.y); o[3] += bfhi(y.y); o[4] += bflo(y.z); o[5] += bfhi(y.z); o[6] += bflo(y.w); o[7] += bfhi(y.w); }
                v4u w; w.x = cvtpk(o[0], o[1]); w.y = cvtpk(o[2], o[3]); w.z = cvtpk(o[4], o[5]); w.w = cvtpk(o[6], o[7]);
                *(v4u*)(T + off) = w;
            }
        )
    }
};

struct EpiOut {
    static constexpr bool PERM = false, AFTER_DRAIN = false;
    const float* x; float* out; const float* mod; float* SS;
    __device__ __forceinline__ void operator()(const f32x4 (&acc)[2][2][4][2], const Unit& u, int wr, int wc, int fr, int fq) const {
        const int row0 = u.pm * 256 + wr * 64 + fr, col0 = u.pn * 256 + wc * 32 + 4 * fq;
        const float* gate = mod + (size_t)(u.pm >> 4) * 3072 + 2048;
        f32x4 gv[2][2];
#pragma unroll
        for (int bj = 0; bj < 2; ++bj)
#pragma unroll
            for (int n = 0; n < 2; ++n) gv[bj][n] = *(const f32x4*)(gate + col0 + bj * 128 + n * 16);
        EPI_ROWS(
            float ss = 0.f;
            _Pragma("unroll") for (int bj = 0; bj < 2; ++bj) _Pragma("unroll") for (int n = 0; n < 2; ++n) {
                const size_t off = (size_t)row * 1024 + col0 + bj * 128 + n * 16;
                const f32x4 xv = *(const f32x4*)(x + off);
                const f32x4 o = xv + gv[bj][n] * acc[ai][bj][m][n];
                ss += (o[0] * o[0] + o[1] * o[1]) + (o[2] * o[2] + o[3] * o[3]);
                *(f32x4*)(out + off) = o;
            }
            ss += __shfl_xor(ss, 16); ss += __shfl_xor(ss, 32);
            if (fq == 0) SS[(size_t)row * 16 + u.pn * 4 + wc] = ss;
        )
    }
};

struct Args { const float* in[19]; float* out; unsigned char* ws; int ph_lo, ph_hi; };
typedef const __attribute__((address_space(4))) Args KArgs;
__device__ __forceinline__ KArgs* kargs() { KArgs* p = (KArgs*)__builtin_amdgcn_kernarg_segment_ptr(); asm volatile("" : "+s"(p)); return p; }

__device__ __forceinline__ int dperm(int p) { const int jj = p >> 1, t = p & 1; return jj < 32 ? (jj + 32 * t) : (64 + (jj - 32) + 32 * t); }
__device__ __forceinline__ int w1_src_col(int n) {
    if (n < 1024) return (n & ~127) + dperm(n & 127);
    if (n < 2048) return n;
    if (n < 2080) return 3072 + (n - 2048);
    if (n < 2304) return -1;
    if (n < 3328) return 2048 + (n - 2304);
    return 3104 + (n - 3328);
}
template <int MODE> __device__ __forceinline__ void transpose_item(const float* W, int K, int ldw, int nblk, bf16* WT, int row_off, LAS float* scr, int item, int lane) {
    const int kb = item / nblk, nb = item % nblk, k0 = 64 * kb, n0 = 32 * nb;
    const int nd = n0 + (lane & 31); const int sc = MODE == 1 ? w1_src_col(nd) : nd;
#pragma unroll 8
    for (int i = 0; i < 32; ++i) { const int kk = 2 * i + (lane >> 5); scr[kk * 33 + (lane & 31)] = sc >= 0 ? W[(size_t)(k0 + kk) * ldw + sc] : 0.f; }
    LDS_WAIT(); asm volatile("" ::: "memory");
    const int c = lane & 7;
#pragma unroll
    for (int j = 0; j < 4; ++j) { const int n = (lane >> 3) + 8 * j; const LAS float* s = scr + (8 * c) * 33 + n;
        v4u o; o.x = pk2(s[0 * 33], s[1 * 33]); o.y = pk2(s[2 * 33], s[3 * 33]); o.z = pk2(s[4 * 33], s[5 * 33]); o.w = pk2(s[6 * 33], s[7 * 33]);
        *(GAS v4u*)(WT + (size_t)(row_off + n0 + n) * K + k0 + 8 * c) = o; }
    LDS_WAIT(); asm volatile("" ::: "memory");
}

__device__ __forceinline__ void p0_prep(KArgs* ap, LAS unsigned char* lds, int vcu, int G, int tid, int lane, int wave) {
    unsigned char* ws = ap->ws;
    float* MOD = (float*)(ws + WS_MOD);
    if (vcu < 24) {
        LAS float* sil = (LAS float*)lds;
        for (int i = tid; i < 9 * 1024; i += 512) { const int r = i >> 10, k = i & 1023; const float cv = r < 8 ? ap->in[1][r * 1024 + k] : ap->in[3][k]; sil[i] = fast_silu(cv); }
        __syncthreads();
        const int j = (vcu * 8 + wave) * 16 + (lane & 15), kq = lane >> 4;
        const float* wm = ap->in[4] + j;
        float acc[9];
#pragma unroll
        for (int r = 0; r < 9; ++r) acc[r] = 0.f;
#pragma unroll 4
        for (int kk = 0; kk < 256; ++kk) { const int k = kq * 256 + kk; const float w = wm[(size_t)k * 3072];
#pragma unroll
            for (int r = 0; r < 9; ++r) acc[r] += sil[r * 1024 + k] * w; }
#pragma unroll
        for (int r = 0; r < 9; ++r) { acc[r] += __shfl_xor(acc[r], 16); acc[r] += __shfl_xor(acc[r], 32); }
        if (lane < 16) { const float bm = ap->in[5][j];
#pragma unroll
            for (int r = 0; r < 9; ++r) MOD[r * 3072 + j] = acc[r] + bm; }
        __syncthreads();
    }
    LAS float* scr = (LAS float*)(lds + wave * 16384);
    const int gw = vcu * NWAVES + wave, NGW = G * NWAVES;
    constexpr int I_ROPE = 32, I_W1 = 16 * (N1 / 32), I_SQ = 16 * 32, I_WP = 4 * 4 * 8;
    constexpr int NITEMS = I_ROPE + I_W1 + 3 * I_SQ + I_WP;
    for (int it = gw; it < NITEMS; it += NGW) {
        int r = it;
        if (r < I_ROPE) { const int e = r * 64 + lane, pos = e >> 5, jf = e & 31;
            const float freq = exp2f(-(float)jf * (13.287712379549449f / 32.0f));
            float rev = (float)pos * freq * 0.15915494309189535f; rev -= floorf(rev);
            float* rt_ = (float*)(ws + WS_ROPE) + 2 * e; rt_[0] = __builtin_amdgcn_cosf(rev); rt_[1] = __builtin_amdgcn_sinf(rev); continue; }
        r -= I_ROPE;
        if (r < I_W1) { transpose_item<1>(ap->in[7], 1024, DIN, N1 / 32, (bf16*)(ws + WS_W1T), 0, scr, r, lane); continue; } r -= I_W1;
        if (r < I_SQ) { transpose_item<0>(ap->in[15], 1024, 1024, 32, (bf16*)(ws + WS_WAT), 0, scr, r, lane); continue; } r -= I_SQ;
        if (r < I_SQ) { transpose_item<0>(ap->in[16], 1024, 1024, 32, (bf16*)(ws + WS_WBT), 0, scr, r, lane); continue; } r -= I_SQ;
        if (r < I_SQ) { transpose_item<0>(ap->in[17], 1024, 1024, 32, (bf16*)(ws + WS_WOT), 0, scr, r, lane); continue; } r -= I_SQ;
        { const int g = r >> 5, ri = r & 31; transpose_item<0>(ap->in[13] + (size_t)g * 65536, 256, 256, 8, (bf16*)(ws + WS_WPT), g * 256, scr, ri, lane); }
    }
}

__device__ __forceinline__ void p1_rows(KArgs* ap, bf16* H, int vcu, int G, int lane, int wave) {
    const float* MOD = (const float*)(ap->ws + WS_MOD);
    const int gw = vcu * NWAVES + wave, NGW = G * NWAVES, per = (MT + NGW - 1) / NGW;
    int cur = -1; f32x4 gs[4], sh[4];
    for (int i = 0; i < per; ++i) {
        const int m = gw * per + i; if (m >= MT) break;
        const float* src = m < MX ? ap->in[0] + (size_t)m * DM : ap->in[2] + (size_t)(m - MX) * DM;
        const int mr = m < MX ? (m >> 12) : 8;
        if (mr != cur) { cur = mr;
#pragma unroll
            for (int j = 0; j < 4; ++j) { const int k = 4 * lane + 256 * j; const f32x4 g = *(const f32x4*)(ap->in[6] + k), sc = *(const f32x4*)(MOD + mr * 3072 + 1024 + k); gs[j] = g * (sc + 1.0f); sh[j] = *(const f32x4*)(MOD + mr * 3072 + k); } }
        f32x4 v[4]; float s = 0.f;
#pragma unroll
        for (int j = 0; j < 4; ++j) { v[j] = *(const f32x4*)(src + 4 * lane + 256 * j); s += (v[j][0] * v[j][0] + v[j][1] * v[j][1]) + (v[j][2] * v[j][2] + v[j][3] * v[j][3]); }
        const float rstd = 1.0f / sqrtf(wave_sum(s) * (1.0f / DM) + EPS);
#pragma unroll
        for (int j = 0; j < 4; ++j) { const f32x4 h = v[j] * rstd * gs[j] + sh[j]; v2u w; w.x = cvtpk(h[0], h[1]); w.y = cvtpk(h[2], h[3]); *(v2u*)(H + (size_t)m * DM + 4 * lane + 256 * j) = w; }
    }
}

__device__ __forceinline__ float logsig16(float x) { const float e = __expf(-fabsf(x)); return (fminf(x, 0.f) - __logf(1.0f + e)) * (1.0f / 16.0f); }
__device__ __forceinline__ void p3_gla_naive(KArgs* ap, LAS unsigned char* lds, int unit, int tid) {
    unsigned char* ws = ap->ws;
    const bf16* Q = (const bf16*)(ws + WS_Q); const bf16* K = (const bf16*)(ws + WS_K); const bf16* V = (const bf16*)(ws + WS_V); const float* LR = (const float*)(ws + WS_LR);
    const int b = unit >> 3, hh = (unit >> 1) & 3, dir = unit & 1;
    bf16* O = (bf16*)(ws + (dir ? WS_OB : WS_OF));
    LAS float* qs = (LAS float*)lds; LAS float* ks = qs + 16 * 128; LAS float* as = ks + 16 * 128;
    const int p = tid & 127, tq = tid >> 7, dsrc = hh * 128 + dperm(p);
    const float* wup = ap->in[dir ? 10 : 8]; const float bb = ap->in[dir ? 11 : 9][dsrc];
    float wv[16];
#pragma unroll
    for (int r = 0; r < 16; ++r) wv[r] = wup[r * 512 + dsrc];
    float S[128];
#pragma unroll
    for (int d = 0; d < 128; ++d) S[d] = 0.f;
    for (int bt = 0; bt < (CTXL + SEQ) / 16; ++bt) {
#pragma unroll
        for (int j = 0; j < 4; ++j) {
            const int tl = tq * 4 + j, s = bt * 16 + tl; const bool lat = s >= CTXL;
            const int tok = lat ? (dir ? SEQ - 1 - (s - CTXL) : (s - CTXL)) : (dir ? CTXL - 1 - s : s);
            const size_t row = lat ? (size_t)b * SEQ + tok : (size_t)MX + b * CTXL + tok;
            const f32x4* lr = (const f32x4*)(LR + row * 32 + dir * 16);
            float gk = bb;
#pragma unroll
            for (int r4 = 0; r4 < 4; ++r4) { const f32x4 l = lr[r4]; gk += l[0] * wv[4 * r4] + l[1] * wv[4 * r4 + 1] + l[2] * wv[4 * r4 + 2] + l[3] * wv[4 * r4 + 3]; }
            as[tl * 128 + p] = __expf(logsig16(gk));
            ks[tl * 128 + p] = bf2f(K[row * 512 + hh * 128 + p]);
            qs[tl * 128 + p] = lat ? bf2f(Q[row * 512 + hh * 128 + p]) : 0.f;
        }
        __syncthreads();
        if (tid < 256) {
            for (int tl = 0; tl < 16; ++tl) {
                const int s = bt * 16 + tl; const bool lat = s >= CTXL;
                const int tok = lat ? (dir ? SEQ - 1 - (s - CTXL) : (s - CTXL)) : (dir ? CTXL - 1 - s : s);
                const size_t row = lat ? (size_t)b * SEQ + tok : (size_t)MX + b * CTXL + tok;
                const float v = bf2f(V[row * 1024 + hh * 256 + tid]);
                float o = 0.f;
#pragma unroll
                for (int d4 = 0; d4 < 32; ++d4) {
                    const f32x4 av = *(const LAS f32x4*)(as + tl * 128 + 4 * d4), kv = *(const LAS f32x4*)(ks + tl * 128 + 4 * d4), qv = *(const LAS f32x4*)(qs + tl * 128 + 4 * d4);
#pragma unroll
                    for (int e = 0; e < 4; ++e) { S[4 * d4 + e] = av[e] * S[4 * d4 + e] + kv[e] * v; o += qv[e] * S[4 * d4 + e]; }
                }
                if (lat) O[row * 1024 + hh * 256 + tid] = (bf16)f2bf(o);
            }
        }
        __syncthreads();
    }
}

__device__ __forceinline__ void p4_stats(KArgs* ap, int vcu, int G, int lane, int wave) {
    const bf16* OF = (const bf16*)(ap->ws + WS_OF); const bf16* OB = (const bf16*)(ap->ws + WS_OB); float* RS = (float*)(ap->ws + WS_RSTD);
    const int gw = vcu * NWAVES + wave, NGW = G * NWAVES;
    for (int m = gw; m < MX; m += NGW) {
        float s = 0.f;
#pragma unroll
        for (int j = 0; j < 2; ++j) { const size_t off = (size_t)m * 1024 + lane * 16 + 8 * j; const v4u f = *(const v4u*)(OF + off), g = *(const v4u*)(OB + off);
            float o;
            o = bflo(f.x) + bflo(g.x); s += o * o; o = bfhi(f.x) + bfhi(g.x); s += o * o; o = bflo(f.y) + bflo(g.y); s += o * o; o = bfhi(f.y) + bfhi(g.y); s += o * o;
            o = bflo(f.z) + bflo(g.z); s += o * o; o = bfhi(f.z) + bfhi(g.z); s += o * o; o = bflo(f.w) + bflo(g.w); s += o * o; o = bfhi(f.w) + bfhi(g.w); s += o * o; }
        s += __shfl_xor(s, 1); s += __shfl_xor(s, 2); s += __shfl_xor(s, 4); s += __shfl_xor(s, 8);
        if ((lane & 15) == 0) RS[(size_t)m * 4 + (lane >> 4)] = 1.0f / sqrtf(s * (1.0f / 256.0f) + EPS);
    }
}

__device__ __forceinline__ void p6_pool(KArgs* ap, int vcu, int G, int tid) {
    const bf16* UB = (const bf16*)(ap->ws + WS_UB); bf16* D = (bf16*)(ap->ws + WS_D);
    const size_t gt = (size_t)vcu * 512 + tid, NT = (size_t)G * 512;
    for (size_t idx = gt; idx < (size_t)MX * 128; idx += NT) {
        const int row = (int)(idx >> 7), ch = (int)(idx & 127), g = ch >> 5, w = 2 << g;
        const int s = row & (SEQ - 1), base = row - s;
        int lo = s - (w >> 1), hi = s + (w - 1 - (w >> 1)); lo = lo < 0 ? 0 : lo; hi = hi > SEQ - 1 ? SEQ - 1 : hi;
        float sum[8];
#pragma unroll
        for (int e = 0; e < 8; ++e) sum[e] = 0.f;
        for (int t = lo; t <= hi; ++t) { const v4u u = *(const v4u*)(UB + (size_t)(base + t) * 1024 + ch * 8);
            sum[0] += bflo(u.x); sum[1] += bfhi(u.x); sum[2] += bflo(u.y); sum[3] += bfhi(u.y); sum[4] += bflo(u.z); sum[5] += bfhi(u.z); sum[6] += bflo(u.w); sum[7] += bfhi(u.w); }
        const float inv = 1.0f / (float)(hi - lo + 1);
        const v4u u = *(const v4u*)(UB + (size_t)row * 1024 + ch * 8);
        v4u o;
        o.x = cvtpk(sum[0] * inv - bflo(u.x), sum[1] * inv - bfhi(u.x)); o.y = cvtpk(sum[2] * inv - bflo(u.y), sum[3] * inv - bfhi(u.y));
        o.z = cvtpk(sum[4] * inv - bflo(u.z), sum[5] * inv - bfhi(u.z)); o.w = cvtpk(sum[6] * inv - bflo(u.w), sum[7] * inv - bfhi(u.w));
        *(v4u*)(D + (size_t)row * 1024 + ch * 8) = o;
    }
}

__device__ __forceinline__ void p11_final(KArgs* ap, int vcu, int G, int lane, int wave) {
    const float* SS = (const float*)(ap->ws + WS_SS); const float* fg = ap->in[18];
    const int gw = vcu * NWAVES + wave, NGW = G * NWAVES;
    f32x4 g[4];
#pragma unroll
    for (int j = 0; j < 4; ++j) g[j] = *(const f32x4*)(fg + 4 * lane + 256 * j);
    for (int m = gw; m < MX; m += NGW) {
        float s = lane < 16 ? SS[(size_t)m * 16 + lane] : 0.f;
        s += __shfl_xor(s, 1); s += __shfl_xor(s, 2); s += __shfl_xor(s, 4); s += __shfl_xor(s, 8);
        s = __shfl(s, 0);
        const float rstd = 1.0f / sqrtf(s * (1.0f / DM) + EPS);
        float* o = ap->out + (size_t)m * DM + 4 * lane;
#pragma unroll
        for (int j = 0; j < 4; ++j) { const f32x4 v = *(const f32x4*)(o + 256 * j); *(f32x4*)(o + 256 * j) = v * rstd * g[j]; }
    }
}

constexpr int NPHASE = 12;
__global__ void __launch_bounds__(NWAVES * 64, 2) fwd_kernel(Args args) {
    extern __shared__ __attribute__((aligned(16))) unsigned char lds_raw[];
    LAS unsigned char* lds = (LAS unsigned char*)lds_raw;
    {
        const int tid = threadIdx.x;
        for (int u = tid; u < (LDS_BYTES - LDSCTL_OFF) / 4; u += NWAVES * 64) ((LAS unsigned*)(lds + LDSCTL_OFF))[u] = 0u;
        __syncthreads();
    }
    const int lo = args.ph_lo, hi = args.ph_hi;
    XcdBarrier bar; bar.bar = (unsigned*)(args.ws + WS_CTL) + CW_BAR; bar.x = 0; bar.st = nullptr;
    if (hi - lo > 1) bar = xcd_barrier_post((unsigned*)(args.ws + WS_CTL) + CW_BAR, (volatile LAS unsigned*)(lds + MISC_OFF) + 8);
#define IN(k) (lo <= (k) && (k) < hi)
#define SEAM(k) do { if ((k) + 1 < hi) xcd_barrier(bar); } while (0)
#define PH_VARS KArgs* ap = kargs(); unsigned char* ws = ap->ws; const int tid = threadIdx.x, lane = tid & 63, wave = __builtin_amdgcn_readfirstlane(tid >> 6); \
    const int G = gridDim.x, bx = blockIdx.x, vcu = (G % 8 == 0) ? (bx % 8) * (G / 8) + bx / 8 : bx; (void)ws; (void)lane; (void)wave; (void)vcu; (void)tid;

    if (IN(0)) { PH_VARS p0_prep(ap, lds, vcu, G, tid, lane, wave); SEAM(0); }
    if (IN(1)) { PH_VARS p1_rows(ap, (bf16*)ap->out, vcu, G, lane, wave); SEAM(1); }
    if (IN(2)) { PH_VARS
        pg8::Gemm g{(const bf16*)ap->out, (const bf16*)(ws + WS_W1T), 1024, 1024, 0}; OrderG1A S; S.init(G, bx);
        EpiQKV E{(bf16*)(ws + WS_Q), (bf16*)(ws + WS_K), (bf16*)(ws + WS_V), (float*)(ws + WS_LR), (const float*)(ws + WS_ROPE)};
        pg8::gemm_phase<EpiQKV, OrderG1A, true, true>(lds, g, S, E);
        SEAM(2);
    }
    if (IN(3)) { PH_VARS if (vcu < 64) p3_gla_naive(ap, lds, vcu, tid); SEAM(3); }
    if (IN(4)) { PH_VARS p4_stats(ap, vcu, G, lane, wave); SEAM(4); }
    if (IN(5)) { PH_VARS
        pg8::Gemm g{(const bf16*)ap->out, (const bf16*)(ws + WS_W1T) + (size_t)N1A * 1024, 1024, 1024, 0}; pg8::StaticOrder S; S.init(MX, N1 - N1A, G, bx);
        EpiB E{(bf16*)(ws + WS_A1), (bf16*)(ws + WS_UB), (bf16*)(ws + WS_ZB), (bf16*)(ws + WS_GA), (bf16*)(ws + WS_GB), (const bf16*)(ws + WS_OF), (const bf16*)(ws + WS_OB), (const float*)(ws + WS_RSTD), ap->in[12]};
        pg8::gemm_phase<EpiB, pg8::StaticOrder, true, true>(lds, g, S, E);
        SEAM(5);
    }
    if (IN(6)) { PH_VARS p6_pool(ap, vcu, G, tid); SEAM(6); }
    if (IN(7)) { PH_VARS
        pg8::Gemm g{(const bf16*)(ws + WS_D), (const bf16*)(ws + WS_WPT), 256, 1024, 256}; pg8::StaticOrder S; S.init(MX, 1024, G, bx);
        EpiMul<0> E{(bf16*)(ws + WS_ZB), nullptr, ap->in[14]};
        pg8::gemm_phase<EpiMul<0>, pg8::StaticOrder, true, true>(lds, g, S, E);
        SEAM(7);
    }
    if (IN(8)) { PH_VARS
        pg8::Gemm g{(const bf16*)(ws + WS_A1), (const bf16*)(ws + WS_WAT), 1024, 1024, 0}; pg8::StaticOrder S; S.init(MX, 1024, G, bx);
        EpiMul<1> E{(bf16*)(ws + WS_GA), nullptr, nullptr};
        pg8::gemm_phase<EpiMul<1>, pg8::StaticOrder, true, true>(lds, g, S, E);
        SEAM(8);
    }
    if (IN(9)) { PH_VARS
        pg8::Gemm g{(const bf16*)(ws + WS_ZB), (const bf16*)(ws + WS_WBT), 1024, 1024, 0}; pg8::StaticOrder S; S.init(MX, 1024, G, bx);
        EpiMul<2> E{(bf16*)(ws + WS_GB), (const bf16*)(ws + WS_GA), nullptr};
        pg8::gemm_phase<EpiMul<2>, pg8::StaticOrder, true, true>(lds, g, S, E);
        SEAM(9);
    }
    if (IN(10)) { PH_VARS
        pg8::Gemm g{(const bf16*)(ws + WS_GB), (const bf16*)(ws + WS_WOT), 1024, 1024, 0}; pg8::StaticOrder S; S.init(MX, 1024, G, bx);
        EpiOut E{ap->in[0], ap->out, (const float*)(ws + WS_MOD), (float*)(ws + WS_SS)};
        pg8::gemm_phase<EpiOut, pg8::StaticOrder, true, true>(lds, g, S, E);
        SEAM(10);
    }
    if (IN(11)) { PH_VARS p11_final(ap, vcu, G, lane, wave); }
#undef IN
#undef SEAM
}

#ifndef MK_ONE_LAUNCH
#define MK_ONE_LAUNCH 1
#endif
extern "C" void kernel_launch(void* const* d_in, const int* in_sizes, int n_in, void* d_out, int out_size, void* d_ws, size_t ws_size, hipStream_t stream) {
    static int grid = 0;
    if (grid == 0) {
        if (n_in != 19 || in_sizes[0] != MX * DM || out_size != MX * DM || ws_size < WS_END) { fprintf(stderr, "kernel_launch: unexpected shapes (n_in %d, in0 %d, out %d, ws %zu); nothing launched\n", n_in, n_in > 0 ? in_sizes[0] : -1, out_size, ws_size); grid = -1; return; }
        int dev = 0, cus = 0, per_cu = 0;
        if (hipGetDevice(&dev) != hipSuccess || hipDeviceGetAttribute(&cus, hipDeviceAttributeMultiprocessorCount, dev) != hipSuccess) { grid = -1; return; }
        if (hipFuncSetAttribute((const void*)fwd_kernel, hipFuncAttributeMaxDynamicSharedMemorySize, LDS_BYTES) != hipSuccess) { fprintf(stderr, "kernel_launch: hipFuncSetAttribute failed\n"); grid = -1; return; }
        if (hipOccupancyMaxActiveBlocksPerMultiprocessor(&per_cu, (const void*)fwd_kernel, NWAVES * 64, LDS_BYTES) != hipSuccess || per_cu < 1) fprintf(stderr, "kernel_launch: occupancy query reports %d workgroups per CU\n", per_cu);
        (void)hipGetLastError();
        grid = cus;
    }
    if (grid < 0) return;
    if (hipMemsetAsync((char*)d_ws + WS_CTL, 0, CTL_ZERO_BYTES, stream) != hipSuccess) { fprintf(stderr, "kernel_launch: memset failed\n"); return; }
    Args a{};
    for (int i = 0; i < 19; ++i) a.in[i] = (const float*)d_in[i];
    a.out = (float*)d_out; a.ws = (unsigned char*)d_ws;
#if MK_ONE_LAUNCH
    a.ph_lo = 0; a.ph_hi = NPHASE;
    hipLaunchKernelGGL(fwd_kernel, dim3(grid), dim3(NWAVES * 64), LDS_BYTES, stream, a);
#else
    for (int p = 0; p < NPHASE; ++p) { a.ph_lo = p; a.ph_hi = p + 1; hipLaunchKernelGGL(fwd_kernel, dim3(grid), dim3(NWAVES * 64), LDS_BYTES, stream, a); }
#endif
    const hipError_t le = hipPeekAtLastError();
    if (le != hipSuccess) fprintf(stderr, "kernel_launch: launch failed: %s\n", hipGetErrorName(le));
}
```

```cpp
#include <hip/hip_runtime.h>
#include <cstdio>
#include <cstdint>
namespace pg8 {
#define PG8_LAS __attribute__((address_space(3)))
typedef unsigned short bf16_t;
typedef short bf16x8 __attribute__((ext_vector_type(8)));
typedef float f32x4 __attribute__((ext_vector_type(4)));
typedef unsigned u32x4 __attribute__((ext_vector_type(4)));
constexpr int BM = 256, BK = 64, HALF = 128, HTB = HALF * BK * 2  , STAGE_BYTES = 8 * HTB, NXCD = 8, WGM = 8;

__host__ __device__ __forceinline__ int lds_byte(int r, int c) { const int st = (r >> 4) * 2 + (c >> 5), rr = r & 15, cc = c & 31, ob = rr * 64 + cc * 2; return st * 1024 + (ob ^ (((ob >> 9) & 1) << 5)); }
__host__ __device__ __forceinline__ void stage_rc(int b, int& R, int& C) { const int st = b / 1024, sb = b % 1024, swz = sb ^ (((sb >> 9) & 1) << 5); R = (st >> 1) * 16 + swz / 64; C = (st & 1) * 32 + (swz % 64) / 2; }
__host__ __device__ __forceinline__ int perm32(int rho) { const int n = rho >> 4, i = rho & 15; return 8 * (i >> 2) + 4 * n + (i & 3); }

__device__ __forceinline__ unsigned cvt_pk_bf16(float lo, float hi) { unsigned r; asm volatile("v_cvt_pk_bf16_f32 %0, %1, %2" : "=v"(r) : "v"(lo), "v"(hi)); return r; }
struct Unit { int pm, pn; };
struct Gemm { const bf16_t* A; const bf16_t* Bt; int K, lda, acol; };

struct StaticOrder {
    int nM, nN, nwg, G, c;
    __host__ __device__ void init(int M, int N, int G_, int c_) { nM = M / BM; nN = N / BM; nwg = nM * nN; G = G_; c = c_; }
    __host__ __device__ bool next(int i, Unit& u) const {
        const long L = (long)i * G + c; if (L >= nwg) return false;
        int wgid = (int)L; { const int q = nwg / NXCD, r = nwg % NXCD, xcd = wgid % NXCD, off = wgid / NXCD; wgid = (xcd < r ? xcd * (q + 1) : r * (q + 1) + (xcd - r) * q) + off; }
        const int nig = WGM * nN, gid = wgid / nig, fm = gid * WGM, gsz = (nM - fm) < WGM ? (nM - fm) : WGM;
        u.pm = fm + ((wgid % nig) % gsz); u.pn = (wgid % nig) / gsz; return true;
    }
    __device__ __forceinline__ void a_ready(const Unit&) const {}
    __device__ __forceinline__ void done(const Unit&) const {}
};

template <class Epi, class Sched, bool ALIGN_EPI = false, bool SP2 = false>
__device__ __forceinline__ void gemm_phase(PG8_LAS unsigned char* lds, const Gemm g, const Sched& S, const Epi& E) {
    const int tid = threadIdx.x, wid = __builtin_amdgcn_readfirstlane(tid >> 6), lane = tid & 63, wr = wid >> 2, wc = wid & 3, fr = lane & 15, fq = lane >> 4;
    int K_ = g.K; asm volatile("" : "+s"(K_));
    const int K = K_, nt = K / BK;
    unsigned voffA[2], voffB[2];
#pragma unroll
    for (int i = 0; i < 2; ++i) { int R, C; stage_rc(tid * 16 + i * 8192, R, C); const int Rb = Epi::PERM ? ((R & ~31) + perm32(R & 31)) : R;
        voffA[i] = (unsigned)(R * g.lda + C) * 2u; voffB[i] = (unsigned)(Rb * K + C) * 2u; }
    const size_t kstep = (size_t)(BK * 2);
    const size_t hstepA = (size_t)HALF * g.lda * 2, hstepB = (size_t)HALF * K * 2;
    const size_t tstepA = 2 * hstepA, tstepB = 2 * hstepB;
    const unsigned ldsw = (unsigned)wid * 1024u;
    const int aoff = lds_byte(wr * 64 + fr, fq * 8), boff = lds_byte(wc * 32 + fr, fq * 8);
#define PG8_SA(b, h) (((b) * 2 + (h)) * HTB)
#define PG8_SB(b, h) ((4 + (b) * 2 + (h)) * HTB)
#define PG8_STAGE(bufoff, gbase, voff) do { _Pragma("unroll") for (int _i = 0; _i < 2; ++_i) \
        __builtin_amdgcn_global_load_lds((const unsigned*)((const char*)(gbase) + (voff)[_i]), (PG8_LAS unsigned*)(lds + (bufoff) + ldsw + _i * 8192), 16, 0, 0); } while (0)
#define PG8_LDA(dst, b, h) do { _Pragma("unroll") for (int m = 0; m < 4; ++m) _Pragma("unroll") for (int k = 0; k < 2; ++k) dst[m][k] = *(const PG8_LAS bf16x8*)(lds + PG8_SA(b, h) + aoff + m * 2048 + k * 1024); } while (0)
#define PG8_LDB(dst, b, h) do { _Pragma("unroll") for (int n = 0; n < 2; ++n) _Pragma("unroll") for (int k = 0; k < 2; ++k) dst[n][k] = *(const PG8_LAS bf16x8*)(lds + PG8_SB(b, h) + boff + n * 2048 + k * 1024); } while (0)
#define PG8_MMA(ai, bj, At, Bt) do { __builtin_amdgcn_s_setprio(1); _Pragma("unroll") for (int m = 0; m < 4; ++m) _Pragma("unroll") for (int n = 0; n < 2; ++n) _Pragma("unroll") for (int k = 0; k < 2; ++k) \
        acc[ai][bj][m][n] = __builtin_amdgcn_mfma_f32_16x16x32_bf16(Bt[n][k], At[m][k], acc[ai][bj][m][n], 0, 0, 0); __builtin_amdgcn_s_setprio(0); } while (0)
#define PG8_WAIT_V(n) asm volatile("s_waitcnt vmcnt(" #n ")" ::: "memory")
#define PG8_WAIT_L(n) asm volatile("s_waitcnt lgkmcnt(" #n ")" ::: "memory")
#define PG8_BAR __builtin_amdgcn_s_barrier()
#define PG8_SCHED __builtin_amdgcn_sched_barrier(0)
    Unit cur, nxt; int ui = 0;
    if (!S.next(0, cur)) return;
    f32x4 acc[2][2][4][2];
#pragma unroll
    for (int a = 0; a < 2; ++a)
#pragma unroll
        for (int b = 0; b < 2; ++b)
#pragma unroll
            for (int m = 0; m < 4; ++m)
#pragma unroll
                for (int n = 0; n < 2; ++n) acc[a][b][m][n] = (f32x4){0.f, 0.f, 0.f, 0.f};
    bf16x8 At[4][2], B0[2][2], B1[2][2];
    const char* cA = (const char*)g.A + (size_t)cur.pm * tstepA + (size_t)cur.pn * (size_t)g.acol * 2; const char* cB = (const char*)g.Bt + (size_t)cur.pn * tstepB;
    S.a_ready(cur);
    if constexpr (SP2) {
        PG8_STAGE(PG8_SB(0, 0), cB, voffB); PG8_STAGE(PG8_SB(0, 1), cB + hstepB, voffB); PG8_STAGE(PG8_SA(0, 0), cA, voffA); PG8_STAGE(PG8_SA(0, 1), cA + hstepA, voffA);
        if (wr == 1) PG8_BAR;
        PG8_WAIT_V(2); PG8_BAR;
        PG8_STAGE(PG8_SB(1, 0), cB + kstep, voffB); PG8_STAGE(PG8_SA(1, 0), cA + kstep, voffA); PG8_STAGE(PG8_SB(1, 1), cB + hstepB + kstep, voffB);
        PG8_WAIT_V(6); PG8_BAR;
    } else {
        PG8_STAGE(PG8_SB(0, 0), cB, voffB); PG8_STAGE(PG8_SA(0, 0), cA, voffA); PG8_STAGE(PG8_SB(0, 1), cB + hstepB, voffB); PG8_STAGE(PG8_SA(0, 1), cA + hstepA, voffA);
        if (wr == 1) PG8_BAR;
        PG8_WAIT_V(4); PG8_BAR;
        PG8_STAGE(PG8_SB(1, 0), cB + kstep, voffB); PG8_STAGE(PG8_SA(1, 0), cA + kstep, voffA); PG8_STAGE(PG8_SB(1, 1), cB + hstepB + kstep, voffB);
        PG8_WAIT_V(6); PG8_BAR;
    }
    for (;;) {
        const bool has_next = S.next(ui + 1, nxt);
        const char* nA = has_next ? (const char*)g.A + (size_t)nxt.pm * tstepA + (size_t)nxt.pn * (size_t)g.acol * 2 : cA; const char* nB = has_next ? (const char*)g.Bt + (size_t)nxt.pn * tstepB : cB;
        for (int t = 0; t < nt; t += 2) {
            const bool last = (t == nt - 2);
            const char* a1 = cA + (size_t)(t + 1) * kstep;
            const char* a2 = last ? nA : cA + (size_t)(t + 2) * kstep; const char* b2 = last ? nB : cB + (size_t)(t + 2) * kstep;
            const char* a3 = a2 + kstep; const char* b3 = b2 + kstep;
            if (last && has_next) S.a_ready(nxt);
            if constexpr (SP2) {
            PG8_LDB(B0, 0, 0); PG8_LDB(B1, 0, 1); PG8_SCHED; PG8_LDA(At, 0, 0); PG8_STAGE(PG8_SA(1, 1), a1 + hstepA, voffA);
            PG8_WAIT_V(8); PG8_WAIT_L(0); PG8_BAR; PG8_MMA(0, 0, At, B0); PG8_MMA(0, 1, At, B1); PG8_BAR; PG8_SCHED;
            PG8_LDA(At, 0, 1); PG8_STAGE(PG8_SB(0, 0), b2, voffB); PG8_STAGE(PG8_SB(0, 1), b2 + hstepB, voffB); PG8_STAGE(PG8_SA(0, 0), a2, voffA);
            PG8_WAIT_V(8); PG8_WAIT_L(0); PG8_BAR; PG8_MMA(1, 0, At, B0); PG8_MMA(1, 1, At, B1); PG8_BAR; PG8_SCHED;
            PG8_LDB(B0, 1, 0); PG8_LDB(B1, 1, 1); PG8_SCHED; PG8_LDA(At, 1, 0); PG8_STAGE(PG8_SA(0, 1), a2 + hstepA, voffA);
            PG8_WAIT_V(8); PG8_WAIT_L(0); PG8_BAR; PG8_MMA(0, 0, At, B0); PG8_MMA(0, 1, At, B1); PG8_BAR; PG8_SCHED;
            PG8_LDA(At, 1, 1); PG8_STAGE(PG8_SB(1, 0), b3, voffB); PG8_STAGE(PG8_SB(1, 1), b3 + hstepB, voffB); PG8_STAGE(PG8_SA(1, 0), a3, voffA);
            PG8_WAIT_V(8); PG8_WAIT_L(0); PG8_BAR; PG8_MMA(1, 0, At, B0); PG8_MMA(1, 1, At, B1); PG8_BAR; PG8_SCHED;
            } else {
            PG8_LDB(B0, 0, 0); PG8_SCHED; PG8_LDA(At, 0, 0); PG8_STAGE(PG8_SA(1, 1), a1 + hstepA, voffA);
            PG8_WAIT_L(8); PG8_BAR; PG8_WAIT_L(0); PG8_MMA(0, 0, At, B0); PG8_BAR; PG8_SCHED;
            PG8_LDB(B1, 0, 1); PG8_STAGE(PG8_SB(0, 0), b2, voffB);
            PG8_BAR; PG8_WAIT_L(0); PG8_MMA(0, 1, At, B1); PG8_BAR;
            PG8_LDA(At, 0, 1); PG8_STAGE(PG8_SA(0, 0), a2, voffA);
            PG8_BAR; PG8_WAIT_L(0); PG8_MMA(1, 0, At, B0); PG8_BAR; PG8_SCHED;
            PG8_STAGE(PG8_SB(0, 1), b2 + hstepB, voffB);
            PG8_WAIT_V(6); PG8_BAR; PG8_MMA(1, 1, At, B1); PG8_BAR;
            PG8_LDB(B0, 1, 0); PG8_SCHED; PG8_LDA(At, 1, 0); PG8_STAGE(PG8_SA(0, 1), a2 + hstepA, voffA);
            PG8_WAIT_L(8); PG8_BAR; PG8_WAIT_L(0); PG8_MMA(0, 0, At, B0); PG8_BAR; PG8_SCHED;
            PG8_LDB(B1, 1, 1); PG8_STAGE(PG8_SB(1, 0), b3, voffB);
            PG8_BAR; PG8_WAIT_L(0); PG8_MMA(0, 1, At, B1); PG8_BAR;
            PG8_LDA(At, 1, 1); PG8_STAGE(PG8_SA(1, 0), a3, voffA);
            PG8_BAR; PG8_WAIT_L(0); PG8_MMA(1, 0, At, B0); PG8_BAR; PG8_SCHED;
            PG8_STAGE(PG8_SB(1, 1), b3 + hstepB, voffB);
            PG8_WAIT_V(6); PG8_BAR; PG8_MMA(1, 1, At, B1); PG8_BAR;
            }
        }
        if constexpr (ALIGN_EPI) { if (wr == 0) PG8_BAR; }
        if constexpr (!Epi::AFTER_DRAIN) { E(acc, cur, wr, wc, fr, fq); S.done(cur); }
        if (!has_next) break;
#pragma unroll
        for (int a = 0; a < 2; ++a)
#pragma unroll
            for (int b = 0; b < 2; ++b)
#pragma unroll
                for (int m = 0; m < 4; ++m)
#pragma unroll
                    for (int n = 0; n < 2; ++n) acc[a][b][m][n] = (f32x4){0.f, 0.f, 0.f, 0.f};
        cur = nxt; cA = nA; cB = nB; ++ui;
        if constexpr (ALIGN_EPI) { if (wr == 1) PG8_BAR; }
    }
    PG8_WAIT_V(0);
    if constexpr (!ALIGN_EPI) { if (wr == 0) PG8_BAR; }
    PG8_BAR;
    if constexpr (Epi::AFTER_DRAIN) { E.fused(acc, cur, wr, wc, fr, fq, lds, wid, lane); S.done(cur); }
#undef PG8_SA
#undef PG8_SB
#undef PG8_STAGE
#undef PG8_LDA
#undef PG8_LDB
#undef PG8_MMA
#undef PG8_WAIT_V
#undef PG8_WAIT_L
#undef PG8_BAR
#undef PG8_SCHED
}
}


#define GAS __attribute__((address_space(1)))
#define LAS __attribute__((address_space(3)))
typedef unsigned short bf16;
typedef unsigned v4u __attribute__((ext_vector_type(4)));
typedef float f32x4 __attribute__((ext_vector_type(4)));
typedef short bf16x8 __attribute__((ext_vector_type(8)));
typedef GAS unsigned gu32;
typedef GAS unsigned long long gu64;
#define RLX_AGENT __ATOMIC_RELAXED, __HIP_MEMORY_SCOPE_AGENT
#define LDS_WAIT() asm volatile("s_waitcnt lgkmcnt(0)" ::: "memory")
#define VM_WAIT() asm volatile("s_waitcnt vmcnt(0)" ::: "memory")
__device__ __forceinline__ unsigned long long rt() { return __builtin_amdgcn_s_memrealtime(); }
__device__ __forceinline__ unsigned f2bf(float f) { unsigned u = __builtin_bit_cast(unsigned, f); return (u + 0x7fffu + ((u >> 16) & 1u)) >> 16; }
__device__ __forceinline__ unsigned pk2(float lo, float hi) { return f2bf(lo) | (f2bf(hi) << 16); }

#define XB_TMO      128
#define XB_XCNT(j)  (256  + 64 * (j))
#define XB_XSUB(j)  (1280 + 64 * (j))
#define XB_XGEN(j)  (2304 + 64 * (j))
#define XB_TOP      3328
#define XB_TOPGEN   3392
#define XCD_BAR_WORDS 3456
#define XB_SPIN_CAP (1u << 18)

__device__ __forceinline__ unsigned xb_ld(unsigned* p)              { return __hip_atomic_load(p, __ATOMIC_RELAXED, __HIP_MEMORY_SCOPE_AGENT); }
__device__ __forceinline__ unsigned xb_add(unsigned* p, unsigned v) { return __hip_atomic_fetch_add(p, v, __ATOMIC_RELAXED, __HIP_MEMORY_SCOPE_AGENT); }
__device__ __forceinline__ unsigned xb_xcc_id() { return (unsigned)__builtin_amdgcn_s_getreg((3 << 11) | 20) & 0xFu; }
#define XB_SPIN(cond, bar) do { unsigned _sp = 0; while (cond) { __builtin_amdgcn_s_sleep(1); \
    if ((++_sp & 255u) == 0u) { if (xb_ld(&(bar)[XB_TMO])) break; if (_sp > XB_SPIN_CAP) { atomicAdd(&(bar)[XB_TMO], 1u); break; } } } } while (0)

struct XcdBarrier {
    unsigned* bar; unsigned x;
    volatile LAS unsigned* st;
};

__device__ __forceinline__ XcdBarrier xcd_barrier_post(unsigned* bar, volatile LAS unsigned* st) {
    XcdBarrier b; b.bar = bar; b.x = xb_xcc_id(); b.st = st;
    if (threadIdx.x == 0) (void)xb_add(&bar[XB_XCNT(b.x)], 1u);
    return b;
}
__device__ __forceinline__ void xcd_barrier_complete(unsigned* bar, unsigned x, unsigned& nloc, unsigned& nx) {
    const unsigned G = gridDim.x * gridDim.y * gridDim.z;
    unsigned sum, cnt, mine, sp = 0u;
    for (;;) {
        sum = 0u; cnt = 0u; mine = 0u;
#pragma unroll
        for (unsigned j = 0; j < 16; ++j) { const unsigned c = xb_ld(&bar[XB_XCNT(j)]); sum += c; cnt += (c > 0u) ? 1u : 0u; mine = (j == x) ? c : mine; }
        if (sum == G) break;
        __builtin_amdgcn_s_sleep(1);
        if ((++sp & 255u) == 0u) { if (xb_ld(&bar[XB_TMO])) break; if (sp > XB_SPIN_CAP) { atomicAdd(&bar[XB_TMO], 1u); break; } }
    }
    nloc = mine > 0u ? mine : 1u; nx = cnt > 0u ? cnt : 1u;
}

__device__ __forceinline__ void xcd_barrier(const XcdBarrier& b) {
    asm volatile("s_waitcnt vmcnt(0)" ::: "memory");
    __syncthreads();
    if (threadIdx.x == 0) {
        unsigned* bar = b.bar;
        __builtin_amdgcn_s_waitcnt(0);
        unsigned nloc = b.st[0], nx = b.st[1];
        if (nloc == 0u) { xcd_barrier_complete(bar, b.x, nloc, nx); b.st[0] = nloc; b.st[1] = nx; }
        const unsigned old = xb_add(&bar[XB_XSUB(b.x)], 1u);
        const unsigned gen = old / nloc;
        if (old + 1u == (gen + 1u) * nloc) {
            __builtin_amdgcn_fence(__ATOMIC_RELEASE, "agent");
            asm volatile("s_waitcnt vmcnt(0)" ::: "memory");
            const unsigned og = xb_add(&bar[XB_TOP], 1u);
            const unsigned tg = og / nx;
            if (og + 1u == (tg + 1u) * nx) xb_add(&bar[XB_TOPGEN], 1u);
            else XB_SPIN(xb_ld(&bar[XB_TOPGEN]) == tg, bar);
            __builtin_amdgcn_fence(__ATOMIC_ACQUIRE, "agent");
            xb_add(&bar[XB_XGEN(b.x)], 1u);
            asm volatile("s_waitcnt vmcnt(0)" ::: "memory");
        } else {
            XB_SPIN(xb_ld(&bar[XB_XGEN(b.x)]) == gen, bar);
            __builtin_amdgcn_fence(__ATOMIC_ACQUIRE, "agent");
            asm volatile("s_waitcnt vmcnt(0)" ::: "memory");
        }
    }
    __syncthreads();
}


constexpr int DM = 1024, NB = 8, SEQ = 4096, CTXL = 256;
constexpr int MX = NB * SEQ, MC = NB * CTXL, MT = MX + MC;
constexpr int DIN = 7200, N1 = 7424, N1A = 2304;
constexpr float EPS = 1e-6f;
constexpr int NWAVES = 8;

constexpr size_t MiB = 1u << 20;
constexpr size_t WS_CTL = 0, CTL_ZERO_BYTES = 1 * MiB;
constexpr size_t WS_MOD = 1 * MiB;
constexpr size_t WS_ROPE = 1 * MiB + 128 * 1024;
constexpr size_t WS_RSTD = 1 * MiB + 256 * 1024;
constexpr size_t WS_SS = 2 * MiB;
constexpr size_t WS_LR = 4 * MiB;
constexpr size_t WS_W1T = 10 * MiB;
constexpr size_t WS_WAT = 25 * MiB, WS_WBT = 27 * MiB, WS_WOT = 29 * MiB, WS_WPT = 31 * MiB;
constexpr size_t WS_Q = 32 * MiB;
constexpr size_t WS_K = 64 * MiB;
constexpr size_t WS_V = 98 * MiB;
constexpr size_t WS_OF = 166 * MiB, WS_OB = 230 * MiB;
constexpr size_t WS_A1 = 294 * MiB, WS_UB = 358 * MiB, WS_ZB = 422 * MiB;
constexpr size_t WS_GA = 32 * MiB, WS_GB = 96 * MiB;
constexpr size_t WS_D = WS_OF;
constexpr size_t WS_END = 486 * MiB;
constexpr int CW_BAR = 4096;

constexpr int RING_BYTES = 131072;
constexpr int LDSCTL_OFF = RING_BYTES, MISC_OFF = LDSCTL_OFF + 320;
constexpr int LDS_BYTES = 147456;

typedef unsigned v2u __attribute__((ext_vector_type(2)));
__device__ __forceinline__ float bf2f(unsigned short u) { return __builtin_bit_cast(float, (unsigned)u << 16); }
__device__ __forceinline__ float bflo(unsigned w) { return __builtin_bit_cast(float, w << 16); }
__device__ __forceinline__ float bfhi(unsigned w) { return __builtin_bit_cast(float, w & 0xffff0000u); }
typedef float f32x2_t __attribute__((ext_vector_type(2))); typedef __bf16 bf16x2_t __attribute__((ext_vector_type(2)));
__device__ __forceinline__ unsigned cvtpk(float lo, float hi) { f32x2_t v = {lo, hi}; bf16x2_t b = __builtin_convertvector(v, bf16x2_t); return __builtin_bit_cast(unsigned, b); }
__device__ __forceinline__ float fast_sigmoid(float x) { return __builtin_amdgcn_rcpf(1.0f + __expf(-x)); }
__device__ __forceinline__ float fast_silu(float x) { return x * fast_sigmoid(x); }
__device__ __forceinline__ float wave_sum(float v) {
#pragma unroll
    for (int o = 1; o < 64; o <<= 1) v += __shfl_xor(v, o);
    return v;
}

struct OrderG1A {
    pg8::StaticOrder so; int G, c;
    __device__ void init(int G_, int c_) { so.init(MX, N1A, G_, c_); G = G_; c = c_; }
    __device__ bool next(int i, pg8::Unit& u) const {
        const int L = i * G + c;
        if (L < so.nwg) return so.next(i, u);
        const int e = L - so.nwg; if (e >= 56) return false;
        u.pm = 128 + e / 7; u.pn = 2 + e % 7; return true;
    }
    __device__ __forceinline__ void a_ready(const pg8::Unit&) const {}
    __device__ __forceinline__ void done(const pg8::Unit&) const {}
};

using pg8::Unit;
#define EPI_ROWS(...) _Pragma("unroll") for (int ai = 0; ai < 2; ++ai) _Pragma("unroll") for (int m = 0; m < 4; ++m) { const int row = row0 + ai * 128 + m * 16; __VA_ARGS__ }

struct EpiQKV {
    static constexpr bool PERM = true, AFTER_DRAIN = false;
    bf16 *Q, *K, *V; float* LR; const float* rope;
    __device__ __forceinline__ void operator()(const f32x4 (&acc)[2][2][4][2], const Unit& u, int wr, int wc, int fr, int fq) const {
        const int pn = u.pn, row0 = u.pm * 256 + wr * 64 + fr, lc0 = wc * 32 + 8 * fq;
        if (pn < 4) {
            const bool isq = pn < 2; const float sc = isq ? 0.08838834764831845f : 1.0f;
            bf16* base = isq ? Q : K; const int colt = (pn & 1) * 256;
            const int jj0 = wc * 16 + 4 * fq, jf = jj0 & 31; const bool colpart = jj0 >= 32;
            EPI_ROWS(
                f32x4 cs0 = (f32x4){1.f, 0.f, 1.f, 0.f}, cs1 = cs0;
                if (row < MX) { const int s = row & 4095, pos = colpart ? (s & 63) : (s >> 6); const f32x4* rp = (const f32x4*)(rope + (pos * 32 + jf) * 2); cs0 = rp[0]; cs1 = rp[1]; }
                _Pragma("unroll") for (int bj = 0; bj < 2; ++bj) {
                    const f32x4 v0 = acc[ai][bj][m][0] * sc, v1 = acc[ai][bj][m][1] * sc;
                    v4u w;
                    w.x = cvtpk(v0[0] * cs0[0] - v0[1] * cs0[1], v0[0] * cs0[1] + v0[1] * cs0[0]);
                    w.y = cvtpk(v0[2] * cs0[2] - v0[3] * cs0[3], v0[2] * cs0[3] + v0[3] * cs0[2]);
                    w.z = cvtpk(v1[0] * cs1[0] - v1[1] * cs1[1], v1[0] * cs1[1] + v1[1] * cs1[0]);
                    w.w = cvtpk(v1[2] * cs1[2] - v1[3] * cs1[3], v1[2] * cs1[3] + v1[3] * cs1[2]);
                    *(v4u*)(base + (size_t)row * 512 + colt + bj * 128 + lc0) = w;
                }
            )
        } else if (pn < 8) {
            const int colt = (pn - 4) * 256;
            EPI_ROWS(
                _Pragma("unroll") for (int bj = 0; bj < 2; ++bj) {
                    const f32x4 v0 = acc[ai][bj][m][0], v1 = acc[ai][bj][m][1];
                    v4u w; w.x = cvtpk(v0[0], v0[1]); w.y = cvtpk(v0[2], v0[3]); w.z = cvtpk(v1[0], v1[1]); w.w = cvtpk(v1[2], v1[3]);
                    *(v4u*)(V + (size_t)row * 1024 + colt + bj * 128 + lc0) = w;
                }
            )
        } else {
            if (wc == 0) {
                EPI_ROWS(
                    *(f32x4*)(LR + (size_t)row * 32 + 8 * fq) = acc[ai][0][m][0];
                    *(f32x4*)(LR + (size_t)row * 32 + 8 * fq + 4) = acc[ai][0][m][1];
                )
            }
        }
    }
};

struct EpiB {
    static constexpr bool PERM = true, AFTER_DRAIN = false;
    bf16 *A1, *UB, *ZB, *GA, *GB; const bf16 *OF, *OB; const float *rstd, *gn;
    __device__ __forceinline__ void operator()(const f32x4 (&acc)[2][2][4][2], const Unit& u, int wr, int wc, int fr, int fq) const {
        const int type = u.pn >> 2, cq = u.pn & 3, row0 = u.pm * 256 + wr * 64 + fr, col0 = cq * 256 + wc * 32 + 8 * fq;
        if (type == 0) {
            f32x4 g0[2], g1[2];
#pragma unroll
            for (int bj = 0; bj < 2; ++bj) { g0[bj] = *(const f32x4*)(gn + bj * 128 + wc * 32 + 8 * fq); g1[bj] = *(const f32x4*)(gn + bj * 128 + wc * 32 + 8 * fq + 4); }
            EPI_ROWS(
                const float r = rstd[(size_t)row * 4 + cq];
                _Pragma("unroll") for (int bj = 0; bj < 2; ++bj) {
                    const size_t off = (size_t)row * 1024 + col0 + bj * 128;
                    const v4u of = *(const v4u*)(OF + off), ob = *(const v4u*)(OB + off);
                    const f32x4 v0 = acc[ai][bj][m][0], v1 = acc[ai][bj][m][1];
                    float o[8];
                    o[0] = bflo(of.x) + bflo(ob.x); o[1] = bfhi(of.x) + bfhi(ob.x); o[2] = bflo(of.y) + bflo(ob.y); o[3] = bfhi(of.y) + bfhi(ob.y);
                    o[4] = bflo(of.z) + bflo(ob.z); o[5] = bfhi(of.z) + bfhi(ob.z); o[6] = bflo(of.w) + bflo(ob.w); o[7] = bfhi(of.w) + bfhi(ob.w);
                    v4u w;
                    w.x = cvtpk(o[0] * r * g0[bj][0] * fast_silu(v0[0]), o[1] * r * g0[bj][1] * fast_silu(v0[1]));
                    w.y = cvtpk(o[2] * r * g0[bj][2] * fast_silu(v0[2]), o[3] * r * g0[bj][3] * fast_silu(v0[3]));
                    w.z = cvtpk(o[4] * r * g1[bj][0] * fast_silu(v1[0]), o[5] * r * g1[bj][1] * fast_silu(v1[1]));
                    w.w = cvtpk(o[6] * r * g1[bj][2] * fast_silu(v1[2]), o[7] * r * g1[bj][3] * fast_silu(v1[3]));
                    *(v4u*)(A1 + off) = w;
                }
            )
        } else if (type == 1) {
            EPI_ROWS(
                _Pragma("unroll") for (int bj = 0; bj < 2; ++bj) {
                    const f32x4 v0 = acc[ai][bj][m][0], v1 = acc[ai][bj][m][1];
                    v4u w; w.x = cvtpk(v0[0], v0[1]); w.y = cvtpk(v0[2], v0[3]); w.z = cvtpk(v1[0], v1[1]); w.w = cvtpk(v1[2], v1[3]);
                    *(v4u*)(UB + (size_t)row * 1024 + col0 + bj * 128) = w;
                }
            )
        } else if (type == 2) {
            EPI_ROWS(
                _Pragma("unroll") for (int bj = 0; bj < 2; ++bj) {
                    const f32x4 v0 = acc[ai][bj][m][0], v1 = acc[ai][bj][m][1];
                    v4u w; w.x = cvtpk(fast_silu(v0[0]), fast_silu(v0[1])); w.y = cvtpk(fast_silu(v0[2]), fast_silu(v0[3])); w.z = cvtpk(fast_silu(v1[0]), fast_silu(v1[1])); w.w = cvtpk(fast_silu(v1[2]), fast_silu(v1[3]));
                    *(v4u*)(ZB + (size_t)row * 1024 + col0 + bj * 128) = w;
                }
            )
        } else {
            bf16* dst = type == 3 ? GA : GB;
            EPI_ROWS(
                _Pragma("unroll") for (int bj = 0; bj < 2; ++bj) {
                    const f32x4 v0 = acc[ai][bj][m][0], v1 = acc[ai][bj][m][1];
                    v4u w; w.x = cvtpk(fast_sigmoid(v0[0]), fast_sigmoid(v0[1])); w.y = cvtpk(fast_sigmoid(v0[2]), fast_sigmoid(v0[3])); w.z = cvtpk(fast_sigmoid(v1[0]), fast_sigmoid(v1[1])); w.w = cvtpk(fast_sigmoid(v1[2]), fast_sigmoid(v1[3]));
                    *(v4u*)(dst + (size_t)row * 1024 + col0 + bj * 128) = w;
                }
            )
        }
    }
};

template <int MODE> struct EpiMul {
    static constexpr bool PERM = true, AFTER_DRAIN = false;
    bf16* T; const bf16* U; const float* vec;
    __device__ __forceinline__ void operator()(const f32x4 (&acc)[2][2][4][2], const Unit& u, int wr, int wc, int fr, int fq) const {
        const int row0 = u.pm * 256 + wr * 64 + fr, col0 = u.pn * 256 + wc * 32 + 8 * fq;
        f32x4 s0[2], s1[2];
#pragma unroll
        for (int bj = 0; bj < 2; ++bj) { s0[bj] = (f32x4){1.f, 1.f, 1.f, 1.f}; s1[bj] = s0[bj]; if (MODE == 0) { s0[bj] = *(const f32x4*)(vec + col0 + bj * 128); s1[bj] = *(const f32x4*)(vec + col0 + bj * 128 + 4); } }
        EPI_ROWS(
            _Pragma("unroll") for (int bj = 0; bj < 2; ++bj) {
                const size_t off = (size_t)row * 1024 + col0 + bj * 128;
                const v4u t = *(const v4u*)(T + off);
                const f32x4 v0 = acc[ai][bj][m][0] * s0[bj], v1 = acc[ai][bj][m][1] * s1[bj];
                float o[8];
                o[0] = v0[0] * bflo(t.x); o[1] = v0[1] * bfhi(t.x); o[2] = v0[2] * bflo(t.y); o[3] = v0[3] * bfhi(t.y);
                o[4] = v1[0] * bflo(t.z); o[5] = v1[1] * bfhi(t.z); o[6] = v1[2] * bflo(t.w); o[7] = v1[3] * bfhi(t.w);
                if (MODE == 2) { const v4u y = *(const v4u*)(U + off);
                    o[0] += bflo(y.x); o[1] += bfhi(y.x); o[2] += bflo(y.y); o[3] += bfhi(y.y); o[4] += bflo(y.z); o[5] += bfhi(y.z); o[6] += bflo(y.w); o[7] += bfhi(y.w); }
                v4u w; w.x = cvtpk(o[0], o[1]); w.y = cvtpk(o[2], o[3]); w.z = cvtpk(o[4], o[5]); w.w = cvtpk(o[6], o[7]);
                *(v4u*)(T + off) = w;
            }
        )
    }
};

struct EpiOut {
    static constexpr bool PERM = false, AFTER_DRAIN = false;
    const float* x; float* out; const float* mod; float* SS;
    __device__ __forceinline__ void operator()(const f32x4 (&acc)[2][2][4][2], const Unit& u, int wr, int wc, int fr, int fq) const {
        const int row0 = u.pm * 256 + wr * 64 + fr, col0 = u.pn * 256 + wc * 32 + 4 * fq;
        const float* gate = mod + (size_t)(u.pm >> 4) * 3072 + 2048;
        f32x4 gv[2][2];
#pragma unroll
        for (int bj = 0; bj < 2; ++bj)
#pragma unroll
            for (int n = 0; n < 2; ++n) gv[bj][n] = *(const f32x4*)(gate + col0 + bj * 128 + n * 16);
        EPI_ROWS(
            float ss = 0.f;
            _Pragma("unroll") for (int bj = 0; bj < 2; ++bj) _Pragma("unroll") for (int n = 0; n < 2; ++n) {
                const size_t off = (size_t)row * 1024 + col0 + bj * 128 + n * 16;
                const f32x4 xv = *(const f32x4*)(x + off);
                const f32x4 o = xv + gv[bj][n] * acc[ai][bj][m][n];
                ss += (o[0] * o[0] + o[1] * o[1]) + (o[2] * o[2] + o[3] * o[3]);
                *(f32x4*)(out + off) = o;
            }
            ss += __shfl_xor(ss, 16); ss += __shfl_xor(ss, 32);
            if (fq == 0) SS[(size_t)row * 16 + u.pn * 4 + wc] = ss;
        )
    }
};

struct Args { const float* in[19]; float* out; unsigned char* ws; int ph_lo, ph_hi; };
typedef const __attribute__((address_space(4))) Args KArgs;
__device__ __forceinline__ KArgs* kargs() { KArgs* p = (KArgs*)__builtin_amdgcn_kernarg_segment_ptr(); asm volatile("" : "+s"(p)); return p; }

__device__ __forceinline__ int dperm(int p) { const int jj = p >> 1, t = p & 1; return jj < 32 ? (jj + 32 * t) : (64 + (jj - 32) + 32 * t); }
__device__ __forceinline__ int w1_src_col(int n) {
    if (n < 1024) return (n & ~127) + dperm(n & 127);
    if (n < 2048) return n;
    if (n < 2080) return 3072 + (n - 2048);
    if (n < 2304) return -1;
    if (n < 3328) return 2048 + (n - 2304);
    return 3104 + (n - 3328);
}
template <int MODE> __device__ __forceinline__ void transpose_item(const float* W, int K, int ldw, int nblk, bf16* WT, int row_off, LAS float* scr, int item, int lane) {
    const int kb = item / nblk, nb = item % nblk, k0 = 64 * kb, n0 = 32 * nb;
    const int nd = n0 + (lane & 31); const int sc = MODE == 1 ? w1_src_col(nd) : nd;
#pragma unroll 8
    for (int i = 0; i < 32; ++i) { const int kk = 2 * i + (lane >> 5); scr[kk * 33 + (lane & 31)] = sc >= 0 ? W[(size_t)(k0 + kk) * ldw + sc] : 0.f; }
    LDS_WAIT(); asm volatile("" ::: "memory");
    const int c = lane & 7;
#pragma unroll
    for (int j = 0; j < 4; ++j) { const int n = (lane >> 3) + 8 * j; const LAS float* s = scr + (8 * c) * 33 + n;
        v4u o; o.x = pk2(s[0 * 33], s[1 * 33]); o.y = pk2(s[2 * 33], s[3 * 33]); o.z = pk2(s[4 * 33], s[5 * 33]); o.w = pk2(s[6 * 33], s[7 * 33]);
        *(GAS v4u*)(WT + (size_t)(row_off + n0 + n) * K + k0 + 8 * c) = o; }
    LDS_WAIT(); asm volatile("" ::: "memory");
}

__device__ __forceinline__ void p0_prep(KArgs* ap, LAS unsigned char* lds, int vcu, int G, int tid, int lane, int wave) {
    unsigned char* ws = ap->ws;
    float* MOD = (float*)(ws + WS_MOD);
    if (vcu < 24) {
        LAS float* sil = (LAS float*)lds;
        for (int i = tid; i < 9 * 1024; i += 512) { const int r = i >> 10, k = i & 1023; const float cv = r < 8 ? ap->in[1][r * 1024 + k] : ap->in[3][k]; sil[i] = fast_silu(cv); }
        __syncthreads();
        const int j = (vcu * 8 + wave) * 16 + (lane & 15), kq = lane >> 4;
        const float* wm = ap->in[4] + j;
        float acc[9];
#pragma unroll
        for (int r = 0; r < 9; ++r) acc[r] = 0.f;
#pragma unroll 4
        for (int kk = 0; kk < 256; ++kk) { const int k = kq * 256 + kk; const float w = wm[(size_t)k * 3072];
#pragma unroll
            for (int r = 0; r < 9; ++r) acc[r] += sil[r * 1024 + k] * w; }
#pragma unroll
        for (int r = 0; r < 9; ++r) { acc[r] += __shfl_xor(acc[r], 16); acc[r] += __shfl_xor(acc[r], 32); }
        if (lane < 16) { const float bm = ap->in[5][j];
#pragma unroll
            for (int r = 0; r < 9; ++r) MOD[r * 3072 + j] = acc[r] + bm; }
        __syncthreads();
    }
    LAS float* scr = (LAS float*)(lds + wave * 16384);
    const int gw = vcu * NWAVES + wave, NGW = G * NWAVES;
    constexpr int I_ROPE = 32, I_W1 = 16 * (N1 / 32), I_SQ = 16 * 32, I_WP = 4 * 4 * 8;
    constexpr int NITEMS = I_ROPE + I_W1 + 3 * I_SQ + I_WP;
    for (int it = gw; it < NITEMS; it += NGW) {
        int r = it;
        if (r < I_ROPE) { const int e = r * 64 + lane, pos = e >> 5, jf = e & 31;
            const float freq = exp2f(-(float)jf * (13.287712379549449f / 32.0f));
            float rev = (float)pos * freq * 0.15915494309189535f; rev -= floorf(rev);
            float* rt_ = (float*)(ws + WS_ROPE) + 2 * e; rt_[0] = __builtin_amdgcn_cosf(rev); rt_[1] = __builtin_amdgcn_sinf(rev); continue; }
        r -= I_ROPE;
        if (r < I_W1) { transpose_item<1>(ap->in[7], 1024, DIN, N1 / 32, (bf16*)(ws + WS_W1T), 0, scr, r, lane); continue; } r -= I_W1;
        if (r < I_SQ) { transpose_item<0>(ap->in[15], 1024, 1024, 32, (bf16*)(ws + WS_WAT), 0, scr, r, lane); continue; } r -= I_SQ;
        if (r < I_SQ) { transpose_item<0>(ap->in[16], 1024, 1024, 32, (bf16*)(ws + WS_WBT), 0, scr, r, lane); continue; } r -= I_SQ;
        if (r < I_SQ) { transpose_item<0>(ap->in[17], 1024, 1024, 32, (bf16*)(ws + WS_WOT), 0, scr, r, lane); continue; } r -= I_SQ;
        { const int g = r >> 5, ri = r & 31; transpose_item<0>(ap->in[13] + (size_t)g * 65536, 256, 256, 8, (bf16*)(ws + WS_WPT), g * 256, scr, ri, lane); }
    }
}

__device__ __forceinline__ void p1_rows(KArgs* ap, bf16* H, int vcu, int G, int lane, int wave) {
    const float* MOD = (const float*)(ap->ws + WS_MOD);
    const int gw = vcu * NWAVES + wave, NGW = G * NWAVES, per = (MT + NGW - 1) / NGW;
    int cur = -1; f32x4 gs[4], sh[4];
    for (int i = 0; i < per; ++i) {
        const int m = gw * per + i; if (m >= MT) break;
        const float* src = m < MX ? ap->in[0] + (size_t)m * DM : ap->in[2] + (size_t)(m - MX) * DM;
        const int mr = m < MX ? (m >> 12) : 8;
        if (mr != cur) { cur = mr;
#pragma unroll
            for (int j = 0; j < 4; ++j) { const int k = 4 * lane + 256 * j; const f32x4 g = *(const f32x4*)(ap->in[6] + k), sc = *(const f32x4*)(MOD + mr * 3072 + 1024 + k); gs[j] = g * (sc + 1.0f); sh[j] = *(const f32x4*)(MOD + mr * 3072 + k); } }
        f32x4 v[4]; float s = 0.f;
#pragma unroll
        for (int j = 0; j < 4; ++j) { v[j] = *(const f32x4*)(src + 4 * lane + 256 * j); s += (v[j][0] * v[j][0] + v[j][1] * v[j][1]) + (v[j][2] * v[j][2] + v[j][3] * v[j][3]); }
        const float rstd = 1.0f / sqrtf(wave_sum(s) * (1.0f / DM) + EPS);
#pragma unroll
        for (int j = 0; j < 4; ++j) { const f32x4 h = v[j] * rstd * gs[j] + sh[j]; v2u w; w.x = cvtpk(h[0], h[1]); w.y = cvtpk(h[2], h[3]); *(v2u*)(H + (size_t)m * DM + 4 * lane + 256 * j) = w; }
    }
}

__device__ __forceinline__ float logsig16(float x) { const float e = __expf(-fabsf(x)); return (fminf(x, 0.f) - __logf(1.0f + e)) * (1.0f / 16.0f); }
__device__ __forceinline__ void p3_gla_naive(KArgs* ap, LAS unsigned char* lds, int unit, int tid) {
    unsigned char* ws = ap->ws;
    const bf16* Q = (const bf16*)(ws + WS_Q); const bf16* K = (const bf16*)(ws + WS_K); const bf16* V = (const bf16*)(ws + WS_V); const float* LR = (const float*)(ws + WS_LR);
    const int b = unit >> 3, hh = (unit >> 1) & 3, dir = unit & 1;
    bf16* O = (bf16*)(ws + (dir ? WS_OB : WS_OF));
    LAS float* qs = (LAS float*)lds; LAS float* ks = qs + 16 * 128; LAS float* as = ks + 16 * 128;
    const int p = tid & 127, tq = tid >> 7, dsrc = hh * 128 + dperm(p);
    const float* wup = ap->in[dir ? 10 : 8]; const float bb = ap->in[dir ? 11 : 9][dsrc];
    float wv[16];
#pragma unroll
    for (int r = 0; r < 16; ++r) wv[r] = wup[r * 512 + dsrc];
    float S[128];
#pragma unroll
    for (int d = 0; d < 128; ++d) S[d] = 0.f;
    for (int bt = 0; bt < (CTXL + SEQ) / 16; ++bt) {
#pragma unroll
        for (int j = 0; j < 4; ++j) {
            const int tl = tq * 4 + j, s = bt * 16 + tl; const bool lat = s >= CTXL;
            const int tok = lat ? (dir ? SEQ - 1 - (s - CTXL) : (s - CTXL)) : (dir ? CTXL - 1 - s : s);
            const size_t row = lat ? (size_t)b * SEQ + tok : (size_t)MX + b * CTXL + tok;
            const f32x4* lr = (const f32x4*)(LR + row * 32 + dir * 16);
            float gk = bb;
#pragma unroll
            for (int r4 = 0; r4 < 4; ++r4) { const f32x4 l = lr[r4]; gk += l[0] * wv[4 * r4] + l[1] * wv[4 * r4 + 1] + l[2] * wv[4 * r4 + 2] + l[3] * wv[4 * r4 + 3]; }
            as[tl * 128 + p] = __expf(logsig16(gk));
            ks[tl * 128 + p] = bf2f(K[row * 512 + hh * 128 + p]);
            qs[tl * 128 + p] = lat ? bf2f(Q[row * 512 + hh * 128 + p]) : 0.f;
        }
        __syncthreads();
        if (tid < 256) {
            for (int tl = 0; tl < 16; ++tl) {
                const int s = bt * 16 + tl; const bool lat = s >= CTXL;
                const int tok = lat ? (dir ? SEQ - 1 - (s - CTXL) : (s - CTXL)) : (dir ? CTXL - 1 - s : s);
                const size_t row = lat ? (size_t)b * SEQ + tok : (size_t)MX + b * CTXL + tok;
                const float v = bf2f(V[row * 1024 + hh * 256 + tid]);
                float o = 0.f;
#pragma unroll
                for (int d4 = 0; d4 < 32; ++d4) {
                    const f32x4 av = *(const LAS f32x4*)(as + tl * 128 + 4 * d4), kv = *(const LAS f32x4*)(ks + tl * 128 + 4 * d4), qv = *(const LAS f32x4*)(qs + tl * 128 + 4 * d4);
#pragma unroll
                    for (int e = 0; e < 4; ++e) { S[4 * d4 + e] = av[e] * S[4 * d4 + e] + kv[e] * v; o += qv[e] * S[4 * d4 + e]; }
                }
                if (lat) O[row * 1024 + hh * 256 + tid] = (bf16)f2bf(o);
            }
        }
        __syncthreads();
    }
}

typedef float f32x16 __attribute__((ext_vector_type(16)));
namespace gl {
constexpr int QT_OFF = 0, QT_STR = 272;
constexpr int KT_OFF = 17408;
constexpr int KTT_OFF = 34816, KTT_STR = 144;
constexpr int VT_OFF = 53248, VT_STR = 144;
constexpr int P_OFF = 62464, P_STR = 144;
constexpr int ST_OFF = 71680, ST_STR = 272;
constexpr int TOT_OFF = 89088;
constexpr int GV_OFF = 93184;
constexpr int LR_OFF = 93696;
constexpr int NSTEP = 68;
}
__device__ __forceinline__ bf16x8 lds_frag(LAS unsigned char* lds, int off) { return *(const LAS bf16x8*)(lds + off); }
__device__ __forceinline__ void p3_gla_mfma(KArgs* ap, LAS unsigned char* lds, int unit, int tid) {
    using namespace gl;
    unsigned char* ws = ap->ws;
    const bf16* Q = (const bf16*)(ws + WS_Q); const bf16* K = (const bf16*)(ws + WS_K); const bf16* V = (const bf16*)(ws + WS_V); const float* LR = (const float*)(ws + WS_LR);
    const int vs = unit & 3, dir = (unit >> 2) & 1, hh = (unit >> 3) & 3, b = unit >> 5;
    bf16* O = (bf16*)(ws + (dir ? WS_OB : WS_OF));
    const int lane = tid & 63, wave = __builtin_amdgcn_readfirstlane(tid >> 6), tg = wave, pp = lane;
    const int r32 = lane & 31, h = lane >> 5;
    float wv0[16], wv1[16], bias0, bias1;
    {
        const float* wup = ap->in[dir ? 10 : 8]; const float* bg = ap->in[dir ? 11 : 9];
        const int d0 = hh * 128 + dperm(2 * pp), d1 = hh * 128 + dperm(2 * pp + 1);
#pragma unroll
        for (int r = 0; r < 16; ++r) { wv0[r] = wup[r * 512 + d0]; wv1[r] = wup[r * 512 + d1]; }
        bias0 = bg[d0]; bias1 = bg[d1];
    }
    for (int i = tid; i < 64 * ST_STR / 4; i += 512) ((LAS unsigned*)(lds + ST_OFF))[i] = 0u;
    f32x16 Sacc;
#pragma unroll
    for (int i = 0; i < 16; ++i) Sacc[i] = 0.f;
    unsigned qreg[8], kreg[8]; v4u vreg; v2u lrreg;
#define GLA_BASE(st) ((st) < 4 ? (MX + b * CTXL + 64 * (dir ? 3 - (st) : (st))) : (b * SEQ + 64 * (dir ? 63 - ((st) - 4) : ((st) - 4))))
#define GLA_LOADS(st) do { const int base_ = GLA_BASE(st); const bool lat_ = (st) >= 4; \
        _Pragma("unroll") for (int e = 0; e < 8; ++e) { const size_t row_ = (size_t)(base_ + 8 * tg + e); \
            kreg[e] = *(const unsigned*)(K + row_ * 512 + hh * 128 + 2 * pp); qreg[e] = lat_ ? *(const unsigned*)(Q + row_ * 512 + hh * 128 + 2 * pp) : 0u; } \
        { const size_t row_ = (size_t)(base_ + (tid >> 3)); vreg = *(const v4u*)(V + row_ * 1024 + hh * 256 + vs * 64 + (tid & 7) * 8); \
          lrreg = *(const v2u*)(LR + row_ * 32 + dir * 16 + (tid & 7) * 2); } } while (0)
    GLA_LOADS(0);
    *(LAS v2u*)(lds + LR_OFF + (tid >> 3) * 64 + (tid & 7) * 8) = lrreg;
    __syncthreads();
    for (int st = 0; st < NSTEP; ++st) {
        const bool lat = st >= 4; const int buf = st & 1;
        float c0[8], c1[8];
#pragma unroll
        for (int e = 0; e < 8; ++e) {
            const LAS f32x4* lr = (const LAS f32x4*)(lds + LR_OFF + buf * 4096 + (8 * tg + e) * 64);
            float g0 = bias0, g1 = bias1;
#pragma unroll
            for (int r4 = 0; r4 < 4; ++r4) { const f32x4 l = lr[r4];
                g0 += l[0] * wv0[4 * r4] + l[1] * wv0[4 * r4 + 1] + l[2] * wv0[4 * r4 + 2] + l[3] * wv0[4 * r4 + 3];
                g1 += l[0] * wv1[4 * r4] + l[1] * wv1[4 * r4 + 1] + l[2] * wv1[4 * r4 + 2] + l[3] * wv1[4 * r4 + 3]; }
            c0[e] = logsig16(g0); c1[e] = logsig16(g1);
        }
        if (dir == 0) {
#pragma unroll
            for (int e = 1; e < 8; ++e) { c0[e] += c0[e - 1]; c1[e] += c1[e - 1]; }
        } else {
#pragma unroll
            for (int e = 6; e >= 0; --e) { c0[e] += c0[e + 1]; c1[e] += c1[e + 1]; }
        }
        { typedef float f32x2v __attribute__((ext_vector_type(2)));
          *(LAS f32x2v*)(lds + TOT_OFF + (tg * 128 + 2 * pp) * 4) = dir == 0 ? (f32x2v){c0[7], c1[7]} : (f32x2v){c0[0], c1[0]}; }
        __syncthreads();
        {
            typedef float f32x2v __attribute__((ext_vector_type(2)));
            float off0 = 0.f, off1 = 0.f, tt0 = 0.f, tt1 = 0.f;
#pragma unroll
            for (int g = 0; g < 8; ++g) { const f32x2v t = *(const LAS f32x2v*)(lds + TOT_OFF + (g * 128 + 2 * pp) * 4); tt0 += t.x; tt1 += t.y;
                const bool use = dir == 0 ? (g < tg) : (g > tg); if (use) { off0 += t.x; off1 += t.y; } }
            if (tg == 0) *(LAS f32x2v*)(lds + GV_OFF + 2 * pp * 4) = (f32x2v){__expf(tt0), __expf(tt1)};
            unsigned kt0[4], kt1[4];
#pragma unroll
            for (int e = 0; e < 8; e += 2) {
                float kk0[2], kk1[2];
#pragma unroll
                for (int u = 0; u < 2; ++u) {
                    const float b0 = c0[e + u] + off0, b1 = c1[e + u] + off1;
                    const float eq0 = __expf(b0), eq1 = __expf(b1), ek0 = __expf(-b0), ek1 = __expf(-b1);
                    const unsigned qw = qreg[e + u], kw = kreg[e + u];
                    const float q0 = bflo(qw) * eq0, q1 = bfhi(qw) * eq1; kk0[u] = bflo(kw) * ek0; kk1[u] = bfhi(kw) * ek1;
                    const int t = 8 * tg + e + u;
                    *(LAS unsigned*)(lds + QT_OFF + t * QT_STR + 4 * pp) = cvtpk(q0, q1);
                    *(LAS unsigned*)(lds + KT_OFF + t * QT_STR + 4 * pp) = cvtpk(kk0[u], kk1[u]);
                }
                kt0[e >> 1] = cvtpk(kk0[0], kk0[1]); kt1[e >> 1] = cvtpk(kk1[0], kk1[1]);
            }
            *(LAS v4u*)(lds + KTT_OFF + (2 * pp) * KTT_STR + 16 * tg) = (v4u){kt0[0], kt0[1], kt0[2], kt0[3]};
            *(LAS v4u*)(lds + KTT_OFF + (2 * pp + 1) * KTT_STR + 16 * tg) = (v4u){kt1[0], kt1[1], kt1[2], kt1[3]};
            { const int t = tid >> 3, v0 = (tid & 7) * 8; LAS unsigned short* vt = (LAS unsigned short*)(lds + VT_OFF + v0 * VT_STR + 2 * t);
              vt[0 * (VT_STR / 2)] = (unsigned short)(vreg.x & 0xffffu); vt[1 * (VT_STR / 2)] = (unsigned short)(vreg.x >> 16);
              vt[2 * (VT_STR / 2)] = (unsigned short)(vreg.y & 0xffffu); vt[3 * (VT_STR / 2)] = (unsigned short)(vreg.y >> 16);
              vt[4 * (VT_STR / 2)] = (unsigned short)(vreg.z & 0xffffu); vt[5 * (VT_STR / 2)] = (unsigned short)(vreg.z >> 16);
              vt[6 * (VT_STR / 2)] = (unsigned short)(vreg.w & 0xffffu); vt[7 * (VT_STR / 2)] = (unsigned short)(vreg.w >> 16); }
        }
        __syncthreads();
        if (st + 1 < NSTEP) GLA_LOADS(st + 1);
        f32x16 oacc;
#pragma unroll
        for (int i = 0; i < 16; ++i) oacc[i] = 0.f;
        const int w4 = wave & 3, it = w4 >> 1, vt_ = w4 & 1;
        if (lat) {
            if (wave < 4) {
                const int jt = w4 >> 1, it2 = w4 & 1;
                f32x16 pacc;
#pragma unroll
                for (int i = 0; i < 16; ++i) pacc[i] = 0.f;
#pragma unroll
                for (int s = 0; s < 8; ++s) {
                    const bf16x8 a = lds_frag(lds, KT_OFF + (32 * jt + r32) * QT_STR + 32 * s + 16 * h);
                    const bf16x8 bq = lds_frag(lds, QT_OFF + (32 * it2 + r32) * QT_STR + 32 * s + 16 * h);
                    pacc = __builtin_amdgcn_mfma_f32_32x32x16_bf16(a, bq, pacc, 0, 0, 0);
                }
                const int i = 32 * it2 + r32;
#pragma unroll
                for (int g = 0; g < 4; ++g) {
                    float pv[4];
#pragma unroll
                    for (int u = 0; u < 4; ++u) { const int j = 32 * jt + 8 * g + 4 * h + u; const bool keep = dir == 0 ? (j <= i) : (j >= i); pv[u] = keep ? pacc[4 * g + u] : 0.f; }
                    *(LAS v2u*)(lds + P_OFF + i * P_STR + 2 * (32 * jt + 8 * g + 4 * h)) = (v2u){cvtpk(pv[0], pv[1]), cvtpk(pv[2], pv[3])};
                }
            } else {
#pragma unroll
                for (int s = 0; s < 8; ++s) {
                    const bf16x8 a = lds_frag(lds, QT_OFF + (32 * it + r32) * QT_STR + 32 * s + 16 * h);
                    const bf16x8 bs = lds_frag(lds, ST_OFF + (32 * vt_ + r32) * ST_STR + 32 * s + 16 * h);
                    oacc = __builtin_amdgcn_mfma_f32_32x32x16_bf16(a, bs, oacc, 0, 0, 0);
                }
            }
        }
        __syncthreads();
        if (lat && wave >= 4) {
#pragma unroll
            for (int s = 0; s < 4; ++s) {
                const bf16x8 a = lds_frag(lds, P_OFF + (32 * it + r32) * P_STR + 32 * s + 16 * h);
                const bf16x8 bv = lds_frag(lds, VT_OFF + (32 * vt_ + r32) * VT_STR + 32 * s + 16 * h);
                oacc = __builtin_amdgcn_mfma_f32_32x32x16_bf16(a, bv, oacc, 0, 0, 0);
            }
            const int base = GLA_BASE(st);
            bf16* op = O + (size_t)base * 1024 + hh * 256 + vs * 64 + 32 * vt_ + r32;
#pragma unroll
            for (int rg = 0; rg < 16; ++rg) { const int i = 32 * it + (rg & 3) + 8 * (rg >> 2) + 4 * h; op[(size_t)i * 1024] = (bf16)(cvtpk(oacc[rg], 0.f) & 0xffffu); }
        }
        {
            const int dt = wave >> 1, vt2 = wave & 1;
#pragma unroll
            for (int s = 0; s < 4; ++s) {
                const bf16x8 a = lds_frag(lds, KTT_OFF + (32 * dt + r32) * KTT_STR + 32 * s + 16 * h);
                const bf16x8 bv = lds_frag(lds, VT_OFF + (32 * vt2 + r32) * VT_STR + 32 * s + 16 * h);
                Sacc = __builtin_amdgcn_mfma_f32_32x32x16_bf16(a, bv, Sacc, 0, 0, 0);
            }
#pragma unroll
            for (int g = 0; g < 4; ++g) {
                const f32x4 gv = *(const LAS f32x4*)(lds + GV_OFF + (32 * dt + 8 * g + 4 * h) * 4);
                Sacc[4 * g] *= gv[0]; Sacc[4 * g + 1] *= gv[1]; Sacc[4 * g + 2] *= gv[2]; Sacc[4 * g + 3] *= gv[3];
                *(LAS v2u*)(lds + ST_OFF + (32 * vt2 + r32) * ST_STR + 2 * (32 * dt + 8 * g + 4 * h)) = (v2u){cvtpk(Sacc[4 * g], Sacc[4 * g + 1]), cvtpk(Sacc[4 * g + 2], Sacc[4 * g + 3])};
            }
        }
        if (st + 1 < NSTEP) *(LAS v2u*)(lds + LR_OFF + (buf ^ 1) * 4096 + (tid >> 3) * 64 + (tid & 7) * 8) = lrreg;
        __syncthreads();
    }
#undef GLA_BASE
#undef GLA_LOADS
}

__device__ __forceinline__ void p4_stats(KArgs* ap, int vcu, int G, int lane, int wave) {
    const bf16* OF = (const bf16*)(ap->ws + WS_OF); const bf16* OB = (const bf16*)(ap->ws + WS_OB); float* RS = (float*)(ap->ws + WS_RSTD);
    const int gw = vcu * NWAVES + wave, NGW = G * NWAVES;
    for (int m = gw; m < MX; m += NGW) {
        float s = 0.f;
#pragma unroll
        for (int j = 0; j < 2; ++j) { const size_t off = (size_t)m * 1024 + lane * 16 + 8 * j; const v4u f = *(const v4u*)(OF + off), g = *(const v4u*)(OB + off);
            float o;
            o = bflo(f.x) + bflo(g.x); s += o * o; o = bfhi(f.x) + bfhi(g.x); s += o * o; o = bflo(f.y) + bflo(g.y); s += o * o; o = bfhi(f.y) + bfhi(g.y); s += o * o;
            o = bflo(f.z) + bflo(g.z); s += o * o; o = bfhi(f.z) + bfhi(g.z); s += o * o; o = bflo(f.w) + bflo(g.w); s += o * o; o = bfhi(f.w) + bfhi(g.w); s += o * o; }
        s += __shfl_xor(s, 1); s += __shfl_xor(s, 2); s += __shfl_xor(s, 4); s += __shfl_xor(s, 8);
        if ((lane & 15) == 0) RS[(size_t)m * 4 + (lane >> 4)] = 1.0f / sqrtf(s * (1.0f / 256.0f) + EPS);
    }
}

__device__ __forceinline__ void p6_pool(KArgs* ap, int vcu, int G, int tid) {
    const bf16* UB = (const bf16*)(ap->ws + WS_UB); bf16* D = (bf16*)(ap->ws + WS_D);
    const size_t gt = (size_t)vcu * 512 + tid, NT = (size_t)G * 512;
    for (size_t idx = gt; idx < (size_t)MX * 128; idx += NT) {
        const int row = (int)(idx >> 7), ch = (int)(idx & 127), g = ch >> 5, w = 2 << g;
        const int s = row & (SEQ - 1), base = row - s;
        int lo = s - (w >> 1), hi = s + (w - 1 - (w >> 1)); lo = lo < 0 ? 0 : lo; hi = hi > SEQ - 1 ? SEQ - 1 : hi;
        float sum[8];
#pragma unroll
        for (int e = 0; e < 8; ++e) sum[e] = 0.f;
        for (int t = lo; t <= hi; ++t) { const v4u u = *(const v4u*)(UB + (size_t)(base + t) * 1024 + ch * 8);
            sum[0] += bflo(u.x); sum[1] += bfhi(u.x); sum[2] += bflo(u.y); sum[3] += bfhi(u.y); sum[4] += bflo(u.z); sum[5] += bfhi(u.z); sum[6] += bflo(u.w); sum[7] += bfhi(u.w); }
        const float inv = 1.0f / (float)(hi - lo + 1);
        const v4u u = *(const v4u*)(UB + (size_t)row * 1024 + ch * 8);
        v4u o;
        o.x = cvtpk(sum[0] * inv - bflo(u.x), sum[1] * inv - bfhi(u.x)); o.y = cvtpk(sum[2] * inv - bflo(u.y), sum[3] * inv - bfhi(u.y));
        o.z = cvtpk(sum[4] * inv - bflo(u.z), sum[5] * inv - bfhi(u.z)); o.w = cvtpk(sum[6] * inv - bflo(u.w), sum[7] * inv - bfhi(u.w));
        *(v4u*)(D + (size_t)row * 1024 + ch * 8) = o;
    }
}

__device__ __forceinline__ void p11_final(KArgs* ap, int vcu, int G, int lane, int wave) {
    const float* SS = (const float*)(ap->ws + WS_SS); const float* fg = ap->in[18];
    const int gw = vcu * NWAVES + wave, NGW = G * NWAVES;
    f32x4 g[4];
#pragma unroll
    for (int j = 0; j < 4; ++j) g[j] = *(const f32x4*)(fg + 4 * lane + 256 * j);
    for (int m = gw; m < MX; m += NGW) {
        float s = lane < 16 ? SS[(size_t)m * 16 + lane] : 0.f;
        s += __shfl_xor(s, 1); s += __shfl_xor(s, 2); s += __shfl_xor(s, 4); s += __shfl_xor(s, 8);
        s = __shfl(s, 0);
        const float rstd = 1.0f / sqrtf(s * (1.0f / DM) + EPS);
        float* o = ap->out + (size_t)m * DM + 4 * lane;
#pragma unroll
        for (int j = 0; j < 4; ++j) { const f32x4 v = *(const f32x4*)(o + 256 * j); *(f32x4*)(o + 256 * j) = v * rstd * g[j]; }
    }
}

constexpr int NPHASE = 12;
__global__ void __launch_bounds__(NWAVES * 64, 2) fwd_kernel(Args args) {
    extern __shared__ __attribute__((aligned(16))) unsigned char lds_raw[];
    LAS unsigned char* lds = (LAS unsigned char*)lds_raw;
    {
        const int tid = threadIdx.x;
        for (int u = tid; u < (LDS_BYTES - LDSCTL_OFF) / 4; u += NWAVES * 64) ((LAS unsigned*)(lds + LDSCTL_OFF))[u] = 0u;
        __syncthreads();
    }
    const int lo = args.ph_lo, hi = args.ph_hi;
    XcdBarrier bar; bar.bar = (unsigned*)(args.ws + WS_CTL) + CW_BAR; bar.x = 0; bar.st = nullptr;
    if (hi - lo > 1) bar = xcd_barrier_post((unsigned*)(args.ws + WS_CTL) + CW_BAR, (volatile LAS unsigned*)(lds + MISC_OFF) + 8);
#define IN(k) (lo <= (k) && (k) < hi)
#define SEAM(k) do { if ((k) + 1 < hi) xcd_barrier(bar); } while (0)
#define PH_VARS KArgs* ap = kargs(); unsigned char* ws = ap->ws; const int tid = threadIdx.x, lane = tid & 63, wave = __builtin_amdgcn_readfirstlane(tid >> 6); \
    const int G = gridDim.x, bx = blockIdx.x, vcu = (G % 8 == 0) ? (bx % 8) * (G / 8) + bx / 8 : bx; (void)ws; (void)lane; (void)wave; (void)vcu; (void)tid;

    if (IN(0)) { PH_VARS p0_prep(ap, lds, vcu, G, tid, lane, wave); SEAM(0); }
    if (IN(1)) { PH_VARS p1_rows(ap, (bf16*)ap->out, vcu, G, lane, wave); SEAM(1); }
    if (IN(2)) { PH_VARS
        pg8::Gemm g{(const bf16*)ap->out, (const bf16*)(ws + WS_W1T), 1024, 1024, 0}; OrderG1A S; S.init(G, bx);
        EpiQKV E{(bf16*)(ws + WS_Q), (bf16*)(ws + WS_K), (bf16*)(ws + WS_V), (float*)(ws + WS_LR), (const float*)(ws + WS_ROPE)};
        pg8::gemm_phase<EpiQKV, OrderG1A, true, true>(lds, g, S, E);
        SEAM(2);
    }
#ifdef GLA_NAIVE
    if (IN(3)) { PH_VARS if (vcu < 64) p3_gla_naive(ap, lds, vcu, tid); SEAM(3); }
#else
    if (IN(3)) { PH_VARS p3_gla_mfma(ap, lds, vcu, tid); SEAM(3); }
#endif
    if (IN(4)) { PH_VARS p4_stats(ap, vcu, G, lane, wave); SEAM(4); }
    if (IN(5)) { PH_VARS
        pg8::Gemm g{(const bf16*)ap->out, (const bf16*)(ws + WS_W1T) + (size_t)N1A * 1024, 1024, 1024, 0}; pg8::StaticOrder S; S.init(MX, N1 - N1A, G, bx);
        EpiB E{(bf16*)(ws + WS_A1), (bf16*)(ws + WS_UB), (bf16*)(ws + WS_ZB), (bf16*)(ws + WS_GA), (bf16*)(ws + WS_GB), (const bf16*)(ws + WS_OF), (const bf16*)(ws + WS_OB), (const float*)(ws + WS_RSTD), ap->in[12]};
        pg8::gemm_phase<EpiB, pg8::StaticOrder, true, true>(lds, g, S, E);
        SEAM(5);
    }
    if (IN(6)) { PH_VARS p6_pool(ap, vcu, G, tid); SEAM(6); }
    if (IN(7)) { PH_VARS
        pg8::Gemm g{(const bf16*)(ws + WS_D), (const bf16*)(ws + WS_WPT), 256, 1024, 256}; pg8::StaticOrder S; S.init(MX, 1024, G, bx);
        EpiMul<0> E{(bf16*)(ws + WS_ZB), nullptr, ap->in[14]};
        pg8::gemm_phase<EpiMul<0>, pg8::StaticOrder, true, true>(lds, g, S, E);
        SEAM(7);
    }
    if (IN(8)) { PH_VARS
        pg8::Gemm g{(const bf16*)(ws + WS_A1), (const bf16*)(ws + WS_WAT), 1024, 1024, 0}; pg8::StaticOrder S; S.init(MX, 1024, G, bx);
        EpiMul<1> E{(bf16*)(ws + WS_GA), nullptr, nullptr};
        pg8::gemm_phase<EpiMul<1>, pg8::StaticOrder, true, true>(lds, g, S, E);
        SEAM(8);
    }
    if (IN(9)) { PH_VARS
        pg8::Gemm g{(const bf16*)(ws + WS_ZB), (const bf16*)(ws + WS_WBT), 1024, 1024, 0}; pg8::StaticOrder S; S.init(MX, 1024, G, bx);
        EpiMul<2> E{(bf16*)(ws + WS_GB), (const bf16*)(ws + WS_GA), nullptr};
        pg8::gemm_phase<EpiMul<2>, pg8::StaticOrder, true, true>(lds, g, S, E);
        SEAM(9);
    }
    if (IN(10)) { PH_VARS
        pg8::Gemm g{(const bf16*)(ws + WS_GB), (const bf16*)(ws + WS_WOT), 1024, 1024, 0}; pg8::StaticOrder S; S.init(MX, 1024, G, bx);
        EpiOut E{ap->in[0], ap->out, (const float*)(ws + WS_MOD), (float*)(ws + WS_SS)};
        pg8::gemm_phase<EpiOut, pg8::StaticOrder, true, true>(lds, g, S, E);
        SEAM(10);
    }
    if (IN(11)) { PH_VARS p11_final(ap, vcu, G, lane, wave); }
#undef IN
#undef SEAM
}

#ifndef MK_ONE_LAUNCH
#define MK_ONE_LAUNCH 1
#endif
extern "C" void kernel_launch(void* const* d_in, const int* in_sizes, int n_in, void* d_out, int out_size, void* d_ws, size_t ws_size, hipStream_t stream) {
    static int grid = 0;
    if (grid == 0) {
        if (n_in != 19 || in_sizes[0] != MX * DM || out_size != MX * DM || ws_size < WS_END) { fprintf(stderr, "kernel_launch: unexpected shapes (n_in %d, in0 %d, out %d, ws %zu); nothing launched\n", n_in, n_in > 0 ? in_sizes[0] : -1, out_size, ws_size); grid = -1; return; }
        int dev = 0, cus = 0, per_cu = 0;
        if (hipGetDevice(&dev) != hipSuccess || hipDeviceGetAttribute(&cus, hipDeviceAttributeMultiprocessorCount, dev) != hipSuccess) { grid = -1; return; }
        if (hipFuncSetAttribute((const void*)fwd_kernel, hipFuncAttributeMaxDynamicSharedMemorySize, LDS_BYTES) != hipSuccess) { fprintf(stderr, "kernel_launch: hipFuncSetAttribute failed\n"); grid = -1; return; }
        if (hipOccupancyMaxActiveBlocksPerMultiprocessor(&per_cu, (const void*)fwd_kernel, NWAVES * 64, LDS_BYTES) != hipSuccess || per_cu < 1) fprintf(stderr, "kernel_launch: occupancy query reports %d workgroups per CU\n", per_cu);
        (void)hipGetLastError();
        grid = cus;
    }
    if (grid < 0) return;
    if (hipMemsetAsync((char*)d_ws + WS_CTL, 0, CTL_ZERO_BYTES, stream) != hipSuccess) { fprintf(stderr, "kernel_launch: memset failed\n"); return; }
    Args a{};
    for (int i = 0; i < 19; ++i) a.in[i] = (const float*)d_in[i];
    a.out = (float*)d_out; a.ws = (unsigned char*)d_ws;
#if MK_ONE_LAUNCH
    a.ph_lo = 0; a.ph_hi = NPHASE;
    hipLaunchKernelGGL(fwd_kernel, dim3(grid), dim3(NWAVES * 64), LDS_BYTES, stream, a);
#else
    for (int p = 0; p < NPHASE; ++p) { a.ph_lo = p; a.ph_hi = p + 1; hipLaunchKernelGGL(fwd_kernel, dim3(grid), dim3(NWAVES * 64), LDS_BYTES, stream, a); }
#endif
    const hipError_t le = hipPeekAtLastError();
    if (le != hipSuccess) fprintf(stderr, "kernel_launch: launch failed: %s\n", hipGetErrorName(le));
}
```

```cpp
#include <hip/hip_runtime.h>
#include <cstdio>
#include <cstdint>
namespace pg8 {
#define PG8_LAS __attribute__((address_space(3)))
typedef unsigned short bf16_t;
typedef short bf16x8 __attribute__((ext_vector_type(8)));
typedef float f32x4 __attribute__((ext_vector_type(4)));
typedef unsigned u32x4 __attribute__((ext_vector_type(4)));
constexpr int BM = 256, BK = 64, HALF = 128, HTB = HALF * BK * 2  , STAGE_BYTES = 8 * HTB, NXCD = 8, WGM = 8;

__host__ __device__ __forceinline__ int lds_byte(int r, int c) { const int st = (r >> 4) * 2 + (c >> 5), rr = r & 15, cc = c & 31, ob = rr * 64 + cc * 2; return st * 1024 + (ob ^ (((ob >> 9) & 1) << 5)); }
__host__ __device__ __forceinline__ void stage_rc(int b, int& R, int& C) { const int st = b / 1024, sb = b % 1024, swz = sb ^ (((sb >> 9) & 1) << 5); R = (st >> 1) * 16 + swz / 64; C = (st & 1) * 32 + (swz % 64) / 2; }
__host__ __device__ __forceinline__ int perm32(int rho) { const int n = rho >> 4, i = rho & 15; return 8 * (i >> 2) + 4 * n + (i & 3); }

__device__ __forceinline__ unsigned cvt_pk_bf16(float lo, float hi) { unsigned r; asm volatile("v_cvt_pk_bf16_f32 %0, %1, %2" : "=v"(r) : "v"(lo), "v"(hi)); return r; }
struct Unit { int pm, pn; };
struct Gemm { const bf16_t* A; const bf16_t* Bt; int K, lda, acol; };

struct StaticOrder {
    int nM, nN, nwg, G, c;
    __host__ __device__ void init(int M, int N, int G_, int c_) { nM = M / BM; nN = N / BM; nwg = nM * nN; G = G_; c = c_; }
    __host__ __device__ bool next(int i, Unit& u) const {
        const long L = (long)i * G + c; if (L >= nwg) return false;
        int wgid = (int)L; { const int q = nwg / NXCD, r = nwg % NXCD, xcd = wgid % NXCD, off = wgid / NXCD; wgid = (xcd < r ? xcd * (q + 1) : r * (q + 1) + (xcd - r) * q) + off; }
        const int nig = WGM * nN, gid = wgid / nig, fm = gid * WGM, gsz = (nM - fm) < WGM ? (nM - fm) : WGM;
        u.pm = fm + ((wgid % nig) % gsz); u.pn = (wgid % nig) / gsz; return true;
    }
    __device__ __forceinline__ void a_ready(const Unit&) const {}
    __device__ __forceinline__ void done(const Unit&) const {}
};

template <class Epi, class Sched, bool ALIGN_EPI = false, bool SP2 = false>
__device__ __forceinline__ void gemm_phase(PG8_LAS unsigned char* lds, const Gemm g, const Sched& S, const Epi& E) {
    const int tid = threadIdx.x, wid = __builtin_amdgcn_readfirstlane(tid >> 6), lane = tid & 63, wr = wid >> 2, wc = wid & 3, fr = lane & 15, fq = lane >> 4;
    int K_ = g.K; asm volatile("" : "+s"(K_));
    const int K = K_, nt = K / BK;
    unsigned voffA[2], voffB[2];
#pragma unroll
    for (int i = 0; i < 2; ++i) { int R, C; stage_rc(tid * 16 + i * 8192, R, C); const int Rb = Epi::PERM ? ((R & ~31) + perm32(R & 31)) : R;
        voffA[i] = (unsigned)(R * g.lda + C) * 2u; voffB[i] = (unsigned)(Rb * K + C) * 2u; }
    const size_t kstep = (size_t)(BK * 2);
    const size_t hstepA = (size_t)HALF * g.lda * 2, hstepB = (size_t)HALF * K * 2;
    const size_t tstepA = 2 * hstepA, tstepB = 2 * hstepB;
    const unsigned ldsw = (unsigned)wid * 1024u;
    const int aoff = lds_byte(wr * 64 + fr, fq * 8), boff = lds_byte(wc * 32 + fr, fq * 8);
#define PG8_SA(b, h) (((b) * 2 + (h)) * HTB)
#define PG8_SB(b, h) ((4 + (b) * 2 + (h)) * HTB)
#define PG8_STAGE(bufoff, gbase, voff) do { _Pragma("unroll") for (int _i = 0; _i < 2; ++_i) \
        __builtin_amdgcn_global_load_lds((const unsigned*)((const char*)(gbase) + (voff)[_i]), (PG8_LAS unsigned*)(lds + (bufoff) + ldsw + _i * 8192), 16, 0, 0); } while (0)
#define PG8_LDA(dst, b, h) do { _Pragma("unroll") for (int m = 0; m < 4; ++m) _Pragma("unroll") for (int k = 0; k < 2; ++k) dst[m][k] = *(const PG8_LAS bf16x8*)(lds + PG8_SA(b, h) + aoff + m * 2048 + k * 1024); } while (0)
#define PG8_LDB(dst, b, h) do { _Pragma("unroll") for (int n = 0; n < 2; ++n) _Pragma("unroll") for (int k = 0; k < 2; ++k) dst[n][k] = *(const PG8_LAS bf16x8*)(lds + PG8_SB(b, h) + boff + n * 2048 + k * 1024); } while (0)
#define PG8_MMA(ai, bj, At, Bt) do { __builtin_amdgcn_s_setprio(1); _Pragma("unroll") for (int m = 0; m < 4; ++m) _Pragma("unroll") for (int n = 0; n < 2; ++n) _Pragma("unroll") for (int k = 0; k < 2; ++k) \
        acc[ai][bj][m][n] = __builtin_amdgcn_mfma_f32_16x16x32_bf16(Bt[n][k], At[m][k], acc[ai][bj][m][n], 0, 0, 0); __builtin_amdgcn_s_setprio(0); } while (0)
#define PG8_WAIT_V(n) asm volatile("s_waitcnt vmcnt(" #n ")" ::: "memory")
#define PG8_WAIT_L(n) asm volatile("s_waitcnt lgkmcnt(" #n ")" ::: "memory")
#define PG8_BAR __builtin_amdgcn_s_barrier()
#define PG8_SCHED __builtin_amdgcn_sched_barrier(0)
    Unit cur, nxt; int ui = 0;
    if (!S.next(0, cur)) return;
    f32x4 acc[2][2][4][2];
#pragma unroll
    for (int a = 0; a < 2; ++a)
#pragma unroll
        for (int b = 0; b < 2; ++b)
#pragma unroll
            for (int m = 0; m < 4; ++m)
#pragma unroll
                for (int n = 0; n < 2; ++n) acc[a][b][m][n] = (f32x4){0.f, 0.f, 0.f, 0.f};
    bf16x8 At[4][2], B0[2][2], B1[2][2];
    const char* cA = (const char*)g.A + (size_t)cur.pm * tstepA + (size_t)cur.pn * (size_t)g.acol * 2; const char* cB = (const char*)g.Bt + (size_t)cur.pn * tstepB;
    S.a_ready(cur);
    if constexpr (SP2) {
        PG8_STAGE(PG8_SB(0, 0), cB, voffB); PG8_STAGE(PG8_SB(0, 1), cB + hstepB, voffB); PG8_STAGE(PG8_SA(0, 0), cA, voffA); PG8_STAGE(PG8_SA(0, 1), cA + hstepA, voffA);
        if (wr == 1) PG8_BAR;
        PG8_WAIT_V(2); PG8_BAR;
        PG8_STAGE(PG8_SB(1, 0), cB + kstep, voffB); PG8_STAGE(PG8_SA(1, 0), cA + kstep, voffA); PG8_STAGE(PG8_SB(1, 1), cB + hstepB + kstep, voffB);
        PG8_WAIT_V(6); PG8_BAR;
    } else {
        PG8_STAGE(PG8_SB(0, 0), cB, voffB); PG8_STAGE(PG8_SA(0, 0), cA, voffA); PG8_STAGE(PG8_SB(0, 1), cB + hstepB, voffB); PG8_STAGE(PG8_SA(0, 1), cA + hstepA, voffA);
        if (wr == 1) PG8_BAR;
        PG8_WAIT_V(4); PG8_BAR;
        PG8_STAGE(PG8_SB(1, 0), cB + kstep, voffB); PG8_STAGE(PG8_SA(1, 0), cA + kstep, voffA); PG8_STAGE(PG8_SB(1, 1), cB + hstepB + kstep, voffB);
        PG8_WAIT_V(6); PG8_BAR;
    }
    for (;;) {
        const bool has_next = S.next(ui + 1, nxt);
        const char* nA = has_next ? (const char*)g.A + (size_t)nxt.pm * tstepA + (size_t)nxt.pn * (size_t)g.acol * 2 : cA; const char* nB = has_next ? (const char*)g.Bt + (size_t)nxt.pn * tstepB : cB;
        for (int t = 0; t < nt; t += 2) {
            const bool last = (t == nt - 2);
            const char* a1 = cA + (size_t)(t + 1) * kstep;
            const char* a2 = last ? nA : cA + (size_t)(t + 2) * kstep; const char* b2 = last ? nB : cB + (size_t)(t + 2) * kstep;
            const char* a3 = a2 + kstep; const char* b3 = b2 + kstep;
            if (last && has_next) S.a_ready(nxt);
            if constexpr (SP2) {
            PG8_LDB(B0, 0, 0); PG8_LDB(B1, 0, 1); PG8_SCHED; PG8_LDA(At, 0, 0); PG8_STAGE(PG8_SA(1, 1), a1 + hstepA, voffA);
            PG8_WAIT_V(8); PG8_WAIT_L(0); PG8_BAR; PG8_MMA(0, 0, At, B0); PG8_MMA(0, 1, At, B1); PG8_BAR; PG8_SCHED;
            PG8_LDA(At, 0, 1); PG8_STAGE(PG8_SB(0, 0), b2, voffB); PG8_STAGE(PG8_SB(0, 1), b2 + hstepB, voffB); PG8_STAGE(PG8_SA(0, 0), a2, voffA);
            PG8_WAIT_V(8); PG8_WAIT_L(0); PG8_BAR; PG8_MMA(1, 0, At, B0); PG8_MMA(1, 1, At, B1); PG8_BAR; PG8_SCHED;
            PG8_LDB(B0, 1, 0); PG8_LDB(B1, 1, 1); PG8_SCHED; PG8_LDA(At, 1, 0); PG8_STAGE(PG8_SA(0, 1), a2 + hstepA, voffA);
            PG8_WAIT_V(8); PG8_WAIT_L(0); PG8_BAR; PG8_MMA(0, 0, At, B0); PG8_MMA(0, 1, At, B1); PG8_BAR; PG8_SCHED;
            PG8_LDA(At, 1, 1); PG8_STAGE(PG8_SB(1, 0), b3, voffB); PG8_STAGE(PG8_SB(1, 1), b3 + hstepB, voffB); PG8_STAGE(PG8_SA(1, 0), a3, voffA);
            PG8_WAIT_V(8); PG8_WAIT_L(0); PG8_BAR; PG8_MMA(1, 0, At, B0); PG8_MMA(1, 1, At, B1); PG8_BAR; PG8_SCHED;
            } else {
            PG8_LDB(B0, 0, 0); PG8_SCHED; PG8_LDA(At, 0, 0); PG8_STAGE(PG8_SA(1, 1), a1 + hstepA, voffA);
            PG8_WAIT_L(8); PG8_BAR; PG8_WAIT_L(0); PG8_MMA(0, 0, At, B0); PG8_BAR; PG8_SCHED;
            PG8_LDB(B1, 0, 1); PG8_STAGE(PG8_SB(0, 0), b2, voffB);
            PG8_BAR; PG8_WAIT_L(0); PG8_MMA(0, 1, At, B1); PG8_BAR;
            PG8_LDA(At, 0, 1); PG8_STAGE(PG8_SA(0, 0), a2, voffA);
            PG8_BAR; PG8_WAIT_L(0); PG8_MMA(1, 0, At, B0); PG8_BAR; PG8_SCHED;
            PG8_STAGE(PG8_SB(0, 1), b2 + hstepB, voffB);
            PG8_WAIT_V(6); PG8_BAR; PG8_MMA(1, 1, At, B1); PG8_BAR;
            PG8_LDB(B0, 1, 0); PG8_SCHED; PG8_LDA(At, 1, 0); PG8_STAGE(PG8_SA(0, 1), a2 + hstepA, voffA);
            PG8_WAIT_L(8); PG8_BAR; PG8_WAIT_L(0); PG8_MMA(0, 0, At, B0); PG8_BAR; PG8_SCHED;
            PG8_LDB(B1, 1, 1); PG8_STAGE(PG8_SB(1, 0), b3, voffB);
            PG8_BAR; PG8_WAIT_L(0); PG8_MMA(0, 1, At, B1); PG8_BAR;
            PG8_LDA(At, 1, 1); PG8_STAGE(PG8_SA(1, 0), a3, voffA);
            PG8_BAR; PG8_WAIT_L(0); PG8_MMA(1, 0, At, B0); PG8_BAR; PG8_SCHED;
            PG8_STAGE(PG8_SB(1, 1), b3 + hstepB, voffB);
            PG8_WAIT_V(6); PG8_BAR; PG8_MMA(1, 1, At, B1); PG8_BAR;
            }
        }
        if constexpr (ALIGN_EPI) { if (wr == 0) PG8_BAR; }
        if constexpr (!Epi::AFTER_DRAIN) { E(acc, cur, wr, wc, fr, fq); S.done(cur); }
        if (!has_next) break;
#pragma unroll
        for (int a = 0; a < 2; ++a)
#pragma unroll
            for (int b = 0; b < 2; ++b)
#pragma unroll
                for (int m = 0; m < 4; ++m)
#pragma unroll
                    for (int n = 0; n < 2; ++n) acc[a][b][m][n] = (f32x4){0.f, 0.f, 0.f, 0.f};
        cur = nxt; cA = nA; cB = nB; ++ui;
        if constexpr (ALIGN_EPI) { if (wr == 1) PG8_BAR; }
    }
    PG8_WAIT_V(0);
    if constexpr (!ALIGN_EPI) { if (wr == 0) PG8_BAR; }
    PG8_BAR;
    if constexpr (Epi::AFTER_DRAIN) { E.fused(acc, cur, wr, wc, fr, fq, lds, wid, lane); S.done(cur); }
#undef PG8_SA
#undef PG8_SB
#undef PG8_STAGE
#undef PG8_LDA
#undef PG8_LDB
#undef PG8_MMA
#undef PG8_WAIT_V
#undef PG8_WAIT_L
#undef PG8_BAR
#undef PG8_SCHED
}
}


#define GAS __attribute__((address_space(1)))
#define LAS __attribute__((address_space(3)))
typedef unsigned short bf16;
typedef unsigned v4u __attribute__((ext_vector_type(4)));
typedef float f32x4 __attribute__((ext_vector_type(4)));
typedef short bf16x8 __attribute__((ext_vector_type(8)));
typedef GAS unsigned gu32;
typedef GAS unsigned long long gu64;
#define RLX_AGENT __ATOMIC_RELAXED, __HIP_MEMORY_SCOPE_AGENT
#define LDS_WAIT() asm volatile("s_waitcnt lgkmcnt(0)" ::: "memory")
#define VM_WAIT() asm volatile("s_waitcnt vmcnt(0)" ::: "memory")
__device__ __forceinline__ unsigned long long rt() { return __builtin_amdgcn_s_memrealtime(); }
__device__ __forceinline__ unsigned f2bf(float f) { unsigned u = __builtin_bit_cast(unsigned, f); return (u + 0x7fffu + ((u >> 16) & 1u)) >> 16; }
__device__ __forceinline__ unsigned pk2(float lo, float hi) { return f2bf(lo) | (f2bf(hi) << 16); }

#define XB_TMO      128
#define XB_XCNT(j)  (256  + 64 * (j))
#define XB_XSUB(j)  (1280 + 64 * (j))
#define XB_XGEN(j)  (2304 + 64 * (j))
#define XB_TOP      3328
#define XB_TOPGEN   3392
#define XCD_BAR_WORDS 3456
#define XB_SPIN_CAP (1u << 18)

__device__ __forceinline__ unsigned xb_ld(unsigned* p)              { return __hip_atomic_load(p, __ATOMIC_RELAXED, __HIP_MEMORY_SCOPE_AGENT); }
__device__ __forceinline__ unsigned xb_add(unsigned* p, unsigned v) { return __hip_atomic_fetch_add(p, v, __ATOMIC_RELAXED, __HIP_MEMORY_SCOPE_AGENT); }
__device__ __forceinline__ unsigned xb_xcc_id() { return (unsigned)__builtin_amdgcn_s_getreg((3 << 11) | 20) & 0xFu; }
#define XB_SPIN(cond, bar) do { unsigned _sp = 0; while (cond) { __builtin_amdgcn_s_sleep(1); \
    if ((++_sp & 255u) == 0u) { if (xb_ld(&(bar)[XB_TMO])) break; if (_sp > XB_SPIN_CAP) { atomicAdd(&(bar)[XB_TMO], 1u); break; } } } } while (0)

struct XcdBarrier {
    unsigned* bar; unsigned x;
    volatile LAS unsigned* st;
};

__device__ __forceinline__ XcdBarrier xcd_barrier_post(unsigned* bar, volatile LAS unsigned* st) {
    XcdBarrier b; b.bar = bar; b.x = xb_xcc_id(); b.st = st;
    if (threadIdx.x == 0) (void)xb_add(&bar[XB_XCNT(b.x)], 1u);
    return b;
}
__device__ __forceinline__ void xcd_barrier_complete(unsigned* bar, unsigned x, unsigned& nloc, unsigned& nx) {
    const unsigned G = gridDim.x * gridDim.y * gridDim.z;
    unsigned sum, cnt, mine, sp = 0u;
    for (;;) {
        sum = 0u; cnt = 0u; mine = 0u;
#pragma unroll
        for (unsigned j = 0; j < 16; ++j) { const unsigned c = xb_ld(&bar[XB_XCNT(j)]); sum += c; cnt += (c > 0u) ? 1u : 0u; mine = (j == x) ? c : mine; }
        if (sum == G) break;
        __builtin_amdgcn_s_sleep(1);
        if ((++sp & 255u) == 0u) { if (xb_ld(&bar[XB_TMO])) break; if (sp > XB_SPIN_CAP) { atomicAdd(&bar[XB_TMO], 1u); break; } }
    }
    nloc = mine > 0u ? mine : 1u; nx = cnt > 0u ? cnt : 1u;
}

__device__ __forceinline__ void xcd_barrier(const XcdBarrier& b) {
    asm volatile("s_waitcnt vmcnt(0)" ::: "memory");
    __syncthreads();
    if (threadIdx.x == 0) {
        unsigned* bar = b.bar;
        __builtin_amdgcn_s_waitcnt(0);
        unsigned nloc = b.st[0], nx = b.st[1];
        if (nloc == 0u) { xcd_barrier_complete(bar, b.x, nloc, nx); b.st[0] = nloc; b.st[1] = nx; }
        const unsigned old = xb_add(&bar[XB_XSUB(b.x)], 1u);
        const unsigned gen = old / nloc;
        if (old + 1u == (gen + 1u) * nloc) {
            __builtin_amdgcn_fence(__ATOMIC_RELEASE, "agent");
            asm volatile("s_waitcnt vmcnt(0)" ::: "memory");
            const unsigned og = xb_add(&bar[XB_TOP], 1u);
            const unsigned tg = og / nx;
            if (og + 1u == (tg + 1u) * nx) xb_add(&bar[XB_TOPGEN], 1u);
            else XB_SPIN(xb_ld(&bar[XB_TOPGEN]) == tg, bar);
            __builtin_amdgcn_fence(__ATOMIC_ACQUIRE, "agent");
            xb_add(&bar[XB_XGEN(b.x)], 1u);
            asm volatile("s_waitcnt vmcnt(0)" ::: "memory");
        } else {
            XB_SPIN(xb_ld(&bar[XB_XGEN(b.x)]) == gen, bar);
            __builtin_amdgcn_fence(__ATOMIC_ACQUIRE, "agent");
            asm volatile("s_waitcnt vmcnt(0)" ::: "memory");
        }
    }
    __syncthreads();
}


constexpr int DM = 1024, NB = 8, SEQ = 4096, CTXL = 256;
constexpr int MX = NB * SEQ, MC = NB * CTXL, MT = MX + MC;
constexpr int DIN = 7200, N1 = 7424, N1A = 2304;
constexpr float EPS = 1e-6f;
constexpr int NWAVES = 8;

constexpr size_t MiB = 1u << 20;
constexpr size_t WS_CTL = 0, CTL_ZERO_BYTES = 1 * MiB;
constexpr size_t WS_MOD = 1 * MiB;
constexpr size_t WS_ROPE = 1 * MiB + 128 * 1024;
constexpr size_t WS_RSTD = 1 * MiB + 256 * 1024;
constexpr size_t WS_SS = 2 * MiB;
constexpr size_t WS_LR = 4 * MiB;
constexpr size_t WS_W1T = 10 * MiB;
constexpr size_t WS_WAT = 25 * MiB, WS_WBT = 27 * MiB, WS_WOT = 29 * MiB, WS_WPT = 31 * MiB;
constexpr size_t WS_Q = 32 * MiB;
constexpr size_t WS_K = 64 * MiB;
constexpr size_t WS_V = 98 * MiB;
constexpr size_t WS_OF = 166 * MiB, WS_OB = 230 * MiB;
constexpr size_t WS_A1 = 294 * MiB, WS_UB = 358 * MiB, WS_ZB = 422 * MiB;
constexpr size_t WS_GA = 32 * MiB, WS_GB = 96 * MiB;
constexpr size_t WS_D = WS_OF;
constexpr size_t WS_END = 496 * MiB;
constexpr int CW_BAR = 4096;

constexpr int RING_BYTES = 131072;
constexpr int LDSCTL_OFF = RING_BYTES, MISC_OFF = LDSCTL_OFF + 320;
constexpr int LDS_BYTES = 147456;

typedef unsigned v2u __attribute__((ext_vector_type(2)));
__device__ __forceinline__ float bf2f(unsigned short u) { return __builtin_bit_cast(float, (unsigned)u << 16); }
__device__ __forceinline__ float bflo(unsigned w) { return __builtin_bit_cast(float, w << 16); }
__device__ __forceinline__ float bfhi(unsigned w) { return __builtin_bit_cast(float, w & 0xffff0000u); }
typedef float f32x2_t __attribute__((ext_vector_type(2))); typedef __bf16 bf16x2_t __attribute__((ext_vector_type(2)));
__device__ __forceinline__ unsigned cvtpk(float lo, float hi) { f32x2_t v = {lo, hi}; bf16x2_t b = __builtin_convertvector(v, bf16x2_t); return __builtin_bit_cast(unsigned, b); }
__device__ __forceinline__ float fast_sigmoid(float x) { return __builtin_amdgcn_rcpf(1.0f + __expf(-x)); }
__device__ __forceinline__ float fast_silu(float x) { return x * fast_sigmoid(x); }
__device__ __forceinline__ float wave_sum(float v) {
#pragma unroll
    for (int o = 1; o < 64; o <<= 1) v += __shfl_xor(v, o);
    return v;
}

struct OrderG1A {
    pg8::StaticOrder so; int G, c;
    __device__ void init(int G_, int c_) { so.init(MX, N1A, G_, c_); G = G_; c = c_; }
    __device__ bool next(int i, pg8::Unit& u) const {
        const int L = i * G + c;
        if (L < so.nwg) return so.next(i, u);
        const int e = L - so.nwg; if (e >= 56) return false;
        u.pm = 128 + e / 7; u.pn = 2 + e % 7; return true;
    }
    __device__ __forceinline__ void a_ready(const pg8::Unit&) const {}
    __device__ __forceinline__ void done(const pg8::Unit&) const {}
};

using pg8::Unit;
#define EPI_ROWS(...) _Pragma("unroll") for (int ai = 0; ai < 2; ++ai) _Pragma("unroll") for (int m = 0; m < 4; ++m) { const int row = row0 + ai * 128 + m * 16; __VA_ARGS__ }

struct EpiQKV {
    static constexpr bool PERM = true, AFTER_DRAIN = false;
    bf16 *Q, *K, *V; float* LR; const float* rope;
    __device__ __forceinline__ void operator()(const f32x4 (&acc)[2][2][4][2], const Unit& u, int wr, int wc, int fr, int fq) const {
        const int pn = u.pn, row0 = u.pm * 256 + wr * 64 + fr, lc0 = wc * 32 + 8 * fq;
        if (pn < 4) {
            const bool isq = pn < 2; const float sc = isq ? 0.08838834764831845f : 1.0f;
            bf16* base = isq ? Q : K; const int colt = (pn & 1) * 256;
            const int jj0 = wc * 16 + 4 * fq, jf = jj0 & 31; const bool colpart = jj0 >= 32;
            EPI_ROWS(
                f32x4 cs0 = (f32x4){1.f, 0.f, 1.f, 0.f}, cs1 = cs0;
                if (row < MX) { const int s = row & 4095, pos = colpart ? (s & 63) : (s >> 6); const f32x4* rp = (const f32x4*)(rope + (pos * 32 + jf) * 2); cs0 = rp[0]; cs1 = rp[1]; }
                _Pragma("unroll") for (int bj = 0; bj < 2; ++bj) {
                    const f32x4 v0 = acc[ai][bj][m][0] * sc, v1 = acc[ai][bj][m][1] * sc;
                    v4u w;
                    w.x = cvtpk(v0[0] * cs0[0] - v0[1] * cs0[1], v0[0] * cs0[1] + v0[1] * cs0[0]);
                    w.y = cvtpk(v0[2] * cs0[2] - v0[3] * cs0[3], v0[2] * cs0[3] + v0[3] * cs0[2]);
                    w.z = cvtpk(v1[0] * cs1[0] - v1[1] * cs1[1], v1[0] * cs1[1] + v1[1] * cs1[0]);
                    w.w = cvtpk(v1[2] * cs1[2] - v1[3] * cs1[3], v1[2] * cs1[3] + v1[3] * cs1[2]);
                    *(v4u*)(base + (size_t)row * 512 + colt + bj * 128 + lc0) = w;
                }
            )
        } else if (pn < 8) {
            const int colt = (pn - 4) * 256;
            EPI_ROWS(
                _Pragma("unroll") for (int bj = 0; bj < 2; ++bj) {
                    const f32x4 v0 = acc[ai][bj][m][0], v1 = acc[ai][bj][m][1];
                    v4u w; w.x = cvtpk(v0[0], v0[1]); w.y = cvtpk(v0[2], v0[3]); w.z = cvtpk(v1[0], v1[1]); w.w = cvtpk(v1[2], v1[3]);
                    *(v4u*)(V + (size_t)row * 1024 + colt + bj * 128 + lc0) = w;
                }
            )
        } else {
            if (wc == 0) {
                EPI_ROWS(
                    *(f32x4*)(LR + (size_t)row * 32 + 8 * fq) = acc[ai][0][m][0];
                    *(f32x4*)(LR + (size_t)row * 32 + 8 * fq + 4) = acc[ai][0][m][1];
                )
            }
        }
    }
};

struct EpiB {
    static constexpr bool PERM = true, AFTER_DRAIN = false;
    bf16 *A1, *UB, *ZB, *GA, *GB; const bf16 *OF, *OB; const float *rstd, *gn;
    __device__ __forceinline__ void operator()(const f32x4 (&acc)[2][2][4][2], const Unit& u, int wr, int wc, int fr, int fq) const {
        const int type = u.pn >> 2, cq = u.pn & 3, row0 = u.pm * 256 + wr * 64 + fr, col0 = cq * 256 + wc * 32 + 8 * fq;
        if (type == 0) {
            f32x4 g0[2], g1[2];
#pragma unroll
            for (int bj = 0; bj < 2; ++bj) { g0[bj] = *(const f32x4*)(gn + bj * 128 + wc * 32 + 8 * fq); g1[bj] = *(const f32x4*)(gn + bj * 128 + wc * 32 + 8 * fq + 4); }
            EPI_ROWS(
                const float r = rstd[(size_t)row * 4 + cq];
                _Pragma("unroll") for (int bj = 0; bj < 2; ++bj) {
                    const size_t off = (size_t)row * 1024 + col0 + bj * 128;
                    const v4u of = *(const v4u*)(OF + off), ob = *(const v4u*)(OB + off);
                    const f32x4 v0 = acc[ai][bj][m][0], v1 = acc[ai][bj][m][1];
                    float o[8];
                    o[0] = bflo(of.x) + bflo(ob.x); o[1] = bfhi(of.x) + bfhi(ob.x); o[2] = bflo(of.y) + bflo(ob.y); o[3] = bfhi(of.y) + bfhi(ob.y);
                    o[4] = bflo(of.z) + bflo(ob.z); o[5] = bfhi(of.z) + bfhi(ob.z); o[6] = bflo(of.w) + bflo(ob.w); o[7] = bfhi(of.w) + bfhi(ob.w);
                    v4u w;
                    w.x = cvtpk(o[0] * r * g0[bj][0] * fast_silu(v0[0]), o[1] * r * g0[bj][1] * fast_silu(v0[1]));
                    w.y = cvtpk(o[2] * r * g0[bj][2] * fast_silu(v0[2]), o[3] * r * g0[bj][3] * fast_silu(v0[3]));
                    w.z = cvtpk(o[4] * r * g1[bj][0] * fast_silu(v1[0]), o[5] * r * g1[bj][1] * fast_silu(v1[1]));
                    w.w = cvtpk(o[6] * r * g1[bj][2] * fast_silu(v1[2]), o[7] * r * g1[bj][3] * fast_silu(v1[3]));
                    *(v4u*)(A1 + off) = w;
                }
            )
        } else if (type == 1) {
            EPI_ROWS(
                _Pragma("unroll") for (int bj = 0; bj < 2; ++bj) {
                    const f32x4 v0 = acc[ai][bj][m][0], v1 = acc[ai][bj][m][1];
                    v4u w; w.x = cvtpk(v0[0], v0[1]); w.y = cvtpk(v0[2], v0[3]); w.z = cvtpk(v1[0], v1[1]); w.w = cvtpk(v1[2], v1[3]);
                    *(v4u*)(UB + (size_t)row * 1024 + col0 + bj * 128) = w;
                }
            )
        } else if (type == 2) {
            EPI_ROWS(
                _Pragma("unroll") for (int bj = 0; bj < 2; ++bj) {
                    const f32x4 v0 = acc[ai][bj][m][0], v1 = acc[ai][bj][m][1];
                    v4u w; w.x = cvtpk(fast_silu(v0[0]), fast_silu(v0[1])); w.y = cvtpk(fast_silu(v0[2]), fast_silu(v0[3])); w.z = cvtpk(fast_silu(v1[0]), fast_silu(v1[1])); w.w = cvtpk(fast_silu(v1[2]), fast_silu(v1[3]));
                    *(v4u*)(ZB + (size_t)row * 1024 + col0 + bj * 128) = w;
                }
            )
        } else {
            bf16* dst = type == 3 ? GA : GB;
            EPI_ROWS(
                _Pragma("unroll") for (int bj = 0; bj < 2; ++bj) {
                    const f32x4 v0 = acc[ai][bj][m][0], v1 = acc[ai][bj][m][1];
                    v4u w; w.x = cvtpk(fast_sigmoid(v0[0]), fast_sigmoid(v0[1])); w.y = cvtpk(fast_sigmoid(v0[2]), fast_sigmoid(v0[3])); w.z = cvtpk(fast_sigmoid(v1[0]), fast_sigmoid(v1[1])); w.w = cvtpk(fast_sigmoid(v1[2]), fast_sigmoid(v1[3]));
                    *(v4u*)(dst + (size_t)row * 1024 + col0 + bj * 128) = w;
                }
            )
        }
    }
};

template <int MODE> struct EpiMul {
    static constexpr bool PERM = true, AFTER_DRAIN = false;
    bf16* T; const bf16* U; const float* vec;
    __device__ __forceinline__ void operator()(const f32x4 (&acc)[2][2][4][2], const Unit& u, int wr, int wc, int fr, int fq) const {
        const int row0 = u.pm * 256 + wr * 64 + fr, col0 = u.pn * 256 + wc * 32 + 8 * fq;
        f32x4 s0[2], s1[2];
#pragma unroll
        for (int bj = 0; bj < 2; ++bj) { s0[bj] = (f32x4){1.f, 1.f, 1.f, 1.f}; s1[bj] = s0[bj]; if (MODE == 0) { s0[bj] = *(const f32x4*)(vec + col0 + bj * 128); s1[bj] = *(const f32x4*)(vec + col0 + bj * 128 + 4); } }
        EPI_ROWS(
            _Pragma("unroll") for (int bj = 0; bj < 2; ++bj) {
                const size_t off = (size_t)row * 1024 + col0 + bj * 128;
                const v4u t = *(const v4u*)(T + off);
                const f32x4 v0 = acc[ai][bj][m][0] * s0[bj], v1 = acc[ai][bj][m][1] * s1[bj];
                float o[8];
                o[0] = v0[0] * bflo(t.x); o[1] = v0[1] * bfhi(t.x); o[2] = v0[2] * bflo(t.y); o[3] = v0[3] * bfhi(t.y);
                o[4] = v1[0] * bflo(t.z); o[5] = v1[1] * bfhi(t.z); o[6] = v1[2] * bflo(t.w); o[7] = v1[3] * bfhi(t.w);
                if (MODE == 2) { const v4u y = *(const v4u*)(U + off);
                    o[0] += bflo(y.x); o[1] += bfhi(y.x); o[2] += bflo(y.y); o[3] += bfhi(y.y); o[4] += bflo(y.z); o[5] += bfhi(y.z); o[6] += bflo(y.w); o[7] += bfhi(y.w); }
                v4u w; w.x = cvtpk(o[0], o[1]); w.y = cvtpk(o[2], o[3]); w.z = cvtpk(o[4], o[5]); w.w = cvtpk(o[6], o[7]);
                *(v4u*)(T + off) = w;
            }
        )
    }
};

struct EpiOut {
    static constexpr bool PERM = false, AFTER_DRAIN = false;
    const float* x; float* out; const float* mod; float* SS;
    __device__ __forceinline__ void operator()(const f32x4 (&acc)[2][2][4][2], const Unit& u, int wr, int wc, int fr, int fq) const {
        const int row0 = u.pm * 256 + wr * 64 + fr, col0 = u.pn * 256 + wc * 32 + 4 * fq;
        const float* gate = mod + (size_t)(u.pm >> 4) * 3072 + 2048;
        f32x4 gv[2][2];
#pragma unroll
        for (int bj = 0; bj < 2; ++bj)
#pragma unroll
            for (int n = 0; n < 2; ++n) gv[bj][n] = *(const f32x4*)(gate + col0 + bj * 128 + n * 16);
        EPI_ROWS(
            float ss = 0.f;
            _Pragma("unroll") for (int bj = 0; bj < 2; ++bj) _Pragma("unroll") for (int n = 0; n < 2; ++n) {
                const size_t off = (size_t)row * 1024 + col0 + bj * 128 + n * 16;
                const f32x4 xv = *(const f32x4*)(x + off);
                const f32x4 o = xv + gv[bj][n] * acc[ai][bj][m][n];
                ss += (o[0] * o[0] + o[1] * o[1]) + (o[2] * o[2] + o[3] * o[3]);
                *(f32x4*)(out + off) = o;
            }
            ss += __shfl_xor(ss, 16); ss += __shfl_xor(ss, 32);
            if (fq == 0) SS[(size_t)row * 16 + u.pn * 4 + wc] = ss;
        )
    }
};

struct Args { const float* in[19]; float* out; unsigned char* ws; int ph_lo, ph_hi; };
typedef const __attribute__((address_space(4))) Args KArgs;
__device__ __forceinline__ KArgs* kargs() { KArgs* p = (KArgs*)__builtin_amdgcn_kernarg_segment_ptr(); asm volatile("" : "+s"(p)); return p; }

__device__ __forceinline__ int dperm(int p) { const int jj = p >> 1, t = p & 1; return jj < 32 ? (jj + 32 * t) : (64 + (jj - 32) + 32 * t); }
__device__ __forceinline__ int w1_src_col(int n) {
    if (n < 1024) return (n & ~127) + dperm(n & 127);
    if (n < 2048) return n;
    if (n < 2080) return 3072 + (n - 2048);
    if (n < 2304) return -1;
    if (n < 3328) return 2048 + (n - 2304);
    return 3104 + (n - 3328);
}
template <int MODE> __device__ __forceinline__ void transpose_item(const float* W, int K, int ldw, int nblk, bf16* WT, int row_off, LAS float* scr, int item, int lane) {
    const int kb = item / nblk, nb = item % nblk, k0 = 64 * kb, n0 = 32 * nb;
    const int nd = n0 + (lane & 31); const int sc = MODE == 1 ? w1_src_col(nd) : nd;
#pragma unroll 8
    for (int i = 0; i < 32; ++i) { const int kk = 2 * i + (lane >> 5); scr[kk * 33 + (lane & 31)] = sc >= 0 ? W[(size_t)(k0 + kk) * ldw + sc] : 0.f; }
    LDS_WAIT(); asm volatile("" ::: "memory");
    const int c = lane & 7;
#pragma unroll
    for (int j = 0; j < 4; ++j) { const int n = (lane >> 3) + 8 * j; const LAS float* s = scr + (8 * c) * 33 + n;
        v4u o; o.x = pk2(s[0 * 33], s[1 * 33]); o.y = pk2(s[2 * 33], s[3 * 33]); o.z = pk2(s[4 * 33], s[5 * 33]); o.w = pk2(s[6 * 33], s[7 * 33]);
        *(GAS v4u*)(WT + (size_t)(row_off + n0 + n) * K + k0 + 8 * c) = o; }
    LDS_WAIT(); asm volatile("" ::: "memory");
}

__device__ __forceinline__ void p0_prep(KArgs* ap, LAS unsigned char* lds, int vcu, int G, int tid, int lane, int wave) {
    unsigned char* ws = ap->ws;
    float* MOD = (float*)(ws + WS_MOD);
    if (vcu < 48) {
        LAS float* sil = (LAS float*)lds;
        for (int i = tid; i < 9 * 1024; i += 512) { const int r = i >> 10, k = i & 1023; const float cv = r < 8 ? ap->in[1][r * 1024 + k] : ap->in[3][k]; sil[i] = fast_silu(cv); }
        __syncthreads();
        const int j = (vcu * 8 + wave) * 8 + (lane & 7), kq = lane >> 3;
        const float* wm = ap->in[4] + j + (size_t)(kq * 128) * 3072;
        float acc[9];
#pragma unroll
        for (int r = 0; r < 9; ++r) acc[r] = 0.f;
        for (int kb = 0; kb < 128; kb += 16) {
            float w[16];
#pragma unroll
            for (int u = 0; u < 16; ++u) w[u] = wm[(size_t)(kb + u) * 3072];
#pragma unroll
            for (int u = 0; u < 16; ++u) {
#pragma unroll
                for (int r = 0; r < 9; ++r) acc[r] += sil[r * 1024 + kq * 128 + kb + u] * w[u]; }
        }
#pragma unroll
        for (int r = 0; r < 9; ++r) { acc[r] += __shfl_xor(acc[r], 8); acc[r] += __shfl_xor(acc[r], 16); acc[r] += __shfl_xor(acc[r], 32); }
        if (lane < 8) { const float bm = ap->in[5][j];
#pragma unroll
            for (int r = 0; r < 9; ++r) MOD[r * 3072 + j] = acc[r] + bm; }
        __syncthreads();
    }
    LAS float* scr = (LAS float*)(lds + wave * 16384);
    const int gw = vcu * NWAVES + wave, NGW = G * NWAVES;
    constexpr int I_ROPE = 32, I_W1 = 16 * (N1 / 32), I_SQ = 16 * 32, I_WP = 4 * 4 * 8;
    constexpr int NITEMS = I_ROPE + I_W1 + 3 * I_SQ + I_WP;
    for (int it = gw; it < NITEMS; it += NGW) {
        int r = it;
        if (r < I_ROPE) { const int e = r * 64 + lane, pos = e >> 5, jf = e & 31;
            const float freq = exp2f(-(float)jf * (13.287712379549449f / 32.0f));
            float rev = (float)pos * freq * 0.15915494309189535f; rev -= floorf(rev);
            float* rt_ = (float*)(ws + WS_ROPE) + 2 * e; rt_[0] = __builtin_amdgcn_cosf(rev); rt_[1] = __builtin_amdgcn_sinf(rev); continue; }
        r -= I_ROPE;
        if (r < I_W1) { transpose_item<1>(ap->in[7], 1024, DIN, N1 / 32, (bf16*)(ws + WS_W1T), 0, scr, r, lane); continue; } r -= I_W1;
        if (r < I_SQ) { transpose_item<0>(ap->in[15], 1024, 1024, 32, (bf16*)(ws + WS_WAT), 0, scr, r, lane); continue; } r -= I_SQ;
        if (r < I_SQ) { transpose_item<0>(ap->in[16], 1024, 1024, 32, (bf16*)(ws + WS_WBT), 0, scr, r, lane); continue; } r -= I_SQ;
        if (r < I_SQ) { transpose_item<0>(ap->in[17], 1024, 1024, 32, (bf16*)(ws + WS_WOT), 0, scr, r, lane); continue; } r -= I_SQ;
        { const int g = r >> 5, ri = r & 31; transpose_item<0>(ap->in[13] + (size_t)g * 65536, 256, 256, 8, (bf16*)(ws + WS_WPT), g * 256, scr, ri, lane); }
    }
}

__device__ __forceinline__ void p1_rows(KArgs* ap, bf16* H, int vcu, int G, int lane, int wave) {
    const float* MOD = (const float*)(ap->ws + WS_MOD);
    const int gw = vcu * NWAVES + wave, NGW = G * NWAVES, per = (MT + NGW - 1) / NGW;
    int cur = -1; f32x4 gs[4], sh[4], v[4], vn[4];
    const int m0 = gw * per;
#define P1_SRC(m) ((m) < MX ? ap->in[0] + (size_t)(m) * DM : ap->in[2] + (size_t)((m) - MX) * DM)
    if (m0 < MT) { const float* src = P1_SRC(m0);
#pragma unroll
        for (int j = 0; j < 4; ++j) v[j] = *(const f32x4*)(src + 4 * lane + 256 * j); }
    for (int i = 0; i < per; ++i) {
        const int m = m0 + i; if (m >= MT) break;
        if (i + 1 < per && m + 1 < MT) { const float* src = P1_SRC(m + 1);
#pragma unroll
            for (int j = 0; j < 4; ++j) vn[j] = *(const f32x4*)(src + 4 * lane + 256 * j); }
        const int mr = m < MX ? (m >> 12) : 8;
        if (mr != cur) { cur = mr;
#pragma unroll
            for (int j = 0; j < 4; ++j) { const int k = 4 * lane + 256 * j; const f32x4 g = *(const f32x4*)(ap->in[6] + k), sc = *(const f32x4*)(MOD + mr * 3072 + 1024 + k); gs[j] = g * (sc + 1.0f); sh[j] = *(const f32x4*)(MOD + mr * 3072 + k); } }
        float s = 0.f;
#pragma unroll
        for (int j = 0; j < 4; ++j) s += (v[j][0] * v[j][0] + v[j][1] * v[j][1]) + (v[j][2] * v[j][2] + v[j][3] * v[j][3]);
        const float rstd = 1.0f / sqrtf(wave_sum(s) * (1.0f / DM) + EPS);
#pragma unroll
        for (int j = 0; j < 4; ++j) { const f32x4 h = v[j] * rstd * gs[j] + sh[j]; v2u w; w.x = cvtpk(h[0], h[1]); w.y = cvtpk(h[2], h[3]); *(v2u*)(H + (size_t)m * DM + 4 * lane + 256 * j) = w; v[j] = vn[j]; }
    }
#undef P1_SRC
}

__device__ __forceinline__ float logsig16(float x) { const float e = __expf(-fabsf(x)); return (fminf(x, 0.f) - __logf(1.0f + e)) * (1.0f / 16.0f); }
__device__ __forceinline__ void p3_gla_naive(KArgs* ap, LAS unsigned char* lds, int unit, int tid) {
    unsigned char* ws = ap->ws;
    const bf16* Q = (const bf16*)(ws + WS_Q); const bf16* K = (const bf16*)(ws + WS_K); const bf16* V = (const bf16*)(ws + WS_V); const float* LR = (const float*)(ws + WS_LR);
    const int b = unit >> 3, hh = (unit >> 1) & 3, dir = unit & 1;
    bf16* O = (bf16*)(ws + (dir ? WS_OB : WS_OF));
    LAS float* qs = (LAS float*)lds; LAS float* ks = qs + 16 * 128; LAS float* as = ks + 16 * 128;
    const int p = tid & 127, tq = tid >> 7, dsrc = hh * 128 + dperm(p);
    const float* wup = ap->in[dir ? 10 : 8]; const float bb = ap->in[dir ? 11 : 9][dsrc];
    float wv[16];
#pragma unroll
    for (int r = 0; r < 16; ++r) wv[r] = wup[r * 512 + dsrc];
    float S[128];
#pragma unroll
    for (int d = 0; d < 128; ++d) S[d] = 0.f;
    for (int bt = 0; bt < (CTXL + SEQ) / 16; ++bt) {
#pragma unroll
        for (int j = 0; j < 4; ++j) {
            const int tl = tq * 4 + j, s = bt * 16 + tl; const bool lat = s >= CTXL;
            const int tok = lat ? (dir ? SEQ - 1 - (s - CTXL) : (s - CTXL)) : (dir ? CTXL - 1 - s : s);
            const size_t row = lat ? (size_t)b * SEQ + tok : (size_t)MX + b * CTXL + tok;
            const f32x4* lr = (const f32x4*)(LR + row * 32 + dir * 16);
            float gk = bb;
#pragma unroll
            for (int r4 = 0; r4 < 4; ++r4) { const f32x4 l = lr[r4]; gk += l[0] * wv[4 * r4] + l[1] * wv[4 * r4 + 1] + l[2] * wv[4 * r4 + 2] + l[3] * wv[4 * r4 + 3]; }
            as[tl * 128 + p] = __expf(logsig16(gk));
            ks[tl * 128 + p] = bf2f(K[row * 512 + hh * 128 + p]);
            qs[tl * 128 + p] = lat ? bf2f(Q[row * 512 + hh * 128 + p]) : 0.f;
        }
        __syncthreads();
        if (tid < 256) {
            for (int tl = 0; tl < 16; ++tl) {
                const int s = bt * 16 + tl; const bool lat = s >= CTXL;
                const int tok = lat ? (dir ? SEQ - 1 - (s - CTXL) : (s - CTXL)) : (dir ? CTXL - 1 - s : s);
                const size_t row = lat ? (size_t)b * SEQ + tok : (size_t)MX + b * CTXL + tok;
                const float v = bf2f(V[row * 1024 + hh * 256 + tid]);
                float o = 0.f;
#pragma unroll
                for (int d4 = 0; d4 < 32; ++d4) {
                    const f32x4 av = *(const LAS f32x4*)(as + tl * 128 + 4 * d4), kv = *(const LAS f32x4*)(ks + tl * 128 + 4 * d4), qv = *(const LAS f32x4*)(qs + tl * 128 + 4 * d4);
#pragma unroll
                    for (int e = 0; e < 4; ++e) { S[4 * d4 + e] = av[e] * S[4 * d4 + e] + kv[e] * v; o += qv[e] * S[4 * d4 + e]; }
                }
                if (lat) O[row * 1024 + hh * 256 + tid] = (bf16)f2bf(o);
            }
        }
        __syncthreads();
    }
}

typedef float f32x16 __attribute__((ext_vector_type(16)));
typedef float f32x2v __attribute__((ext_vector_type(2)));
constexpr int NCHUNK = MT / 64;
constexpr size_t WS_QT0 = 294 * MiB, WS_KT0 = 326 * MiB, WS_KTT0 = 360 * MiB;
constexpr size_t WS_DIR1 = 100 * MiB;
constexpr size_t OUT_G = 72 * MiB;
__device__ __forceinline__ void p3a_decay(KArgs* ap, LAS unsigned char* lds, int vcu, int G, int tid) {
    unsigned char* ws = ap->ws;
    const bf16* Q = (const bf16*)(ws + WS_Q); const bf16* K = (const bf16*)(ws + WS_K); const float* LR = (const float*)(ws + WS_LR);
    const int lane = tid & 63, tg = __builtin_amdgcn_readfirstlane(tid >> 6), pp = lane;
    int cur = -1; float wv0[16], wv1[16], bias0 = 0.f, bias1 = 0.f;
    int n = 0;
    for (int it = vcu; it < NCHUNK * 8; it += G, ++n) {
        const int hd = it & 7, hh = hd >> 1, dir = hd & 1, cg = it >> 3; const bool lat = cg < MX / 64;
        if (hd != cur) { cur = hd;
            const float* wup = ap->in[dir ? 10 : 8]; const float* bg = ap->in[dir ? 11 : 9];
            const int d0 = hh * 128 + dperm(2 * pp), d1 = hh * 128 + dperm(2 * pp + 1);
#pragma unroll
            for (int r = 0; r < 16; ++r) { wv0[r] = wup[r * 512 + d0]; wv1[r] = wup[r * 512 + d1]; }
            bias0 = bg[d0]; bias1 = bg[d1]; }
        const size_t row0 = (size_t)cg * 64 + 8 * tg;
        unsigned qreg[8], kreg[8];
#pragma unroll
        for (int e = 0; e < 8; ++e) { kreg[e] = *(const unsigned*)(K + (row0 + e) * 512 + hh * 128 + 2 * pp); qreg[e] = lat ? *(const unsigned*)(Q + (row0 + e) * 512 + hh * 128 + 2 * pp) : 0u; }
        float c0[8], c1[8];
#pragma unroll
        for (int e = 0; e < 8; ++e) {
            const f32x4* lr = (const f32x4*)(LR + (row0 + e) * 32 + dir * 16);
            float g0 = bias0, g1 = bias1;
#pragma unroll
            for (int r4 = 0; r4 < 4; ++r4) { const f32x4 l = lr[r4];
                g0 += l[0] * wv0[4 * r4] + l[1] * wv0[4 * r4 + 1] + l[2] * wv0[4 * r4 + 2] + l[3] * wv0[4 * r4 + 3];
                g1 += l[0] * wv1[4 * r4] + l[1] * wv1[4 * r4 + 1] + l[2] * wv1[4 * r4 + 2] + l[3] * wv1[4 * r4 + 3]; }
            c0[e] = logsig16(g0); c1[e] = logsig16(g1);
        }
        if (dir == 0) {
#pragma unroll
            for (int e = 1; e < 8; ++e) { c0[e] += c0[e - 1]; c1[e] += c1[e - 1]; }
        } else {
#pragma unroll
            for (int e = 6; e >= 0; --e) { c0[e] += c0[e + 1]; c1[e] += c1[e + 1]; }
        }
        LAS unsigned char* tot = lds + (n & 1) * 4096;
        *(LAS f32x2v*)(tot + (tg * 128 + 2 * pp) * 4) = dir == 0 ? (f32x2v){c0[7], c1[7]} : (f32x2v){c0[0], c1[0]};
        __syncthreads();
        float off0 = 0.f, off1 = 0.f, tt0 = 0.f, tt1 = 0.f;
#pragma unroll
        for (int g = 0; g < 8; ++g) { const f32x2v t = *(const LAS f32x2v*)(tot + (g * 128 + 2 * pp) * 4); tt0 += t.x; tt1 += t.y;
            const bool use = dir == 0 ? (g < tg) : (g > tg); if (use) { off0 += t.x; off1 += t.y; } }
        if (tg == 0) *(f32x2v*)((float*)((unsigned char*)ap->out + OUT_G) + ((size_t)(dir * NCHUNK + cg) * 4 + hh) * 128 + 2 * pp) = (f32x2v){__expf(tt0), __expf(tt1)};
        bf16* QT = (bf16*)(ws + WS_QT0 + dir * WS_DIR1); bf16* KT = (bf16*)(ws + WS_KT0 + dir * WS_DIR1); bf16* KTT = (bf16*)(ws + WS_KTT0 + dir * WS_DIR1);
        unsigned kt0[4], kt1[4];
#pragma unroll
        for (int e = 0; e < 8; e += 2) {
            float kk0[2], kk1[2];
#pragma unroll
            for (int u = 0; u < 2; ++u) {
                const float b0 = c0[e + u] + off0, b1 = c1[e + u] + off1;
                const float eq0 = __expf(b0), eq1 = __expf(b1), ek0 = __expf(-b0), ek1 = __expf(-b1);
                const unsigned qw = qreg[e + u], kw = kreg[e + u];
                kk0[u] = bflo(kw) * ek0; kk1[u] = bfhi(kw) * ek1;
                if (lat) *(unsigned*)(QT + (row0 + e + u) * 512 + hh * 128 + 2 * pp) = cvtpk(bflo(qw) * eq0, bfhi(qw) * eq1);
                *(unsigned*)(KT + (row0 + e + u) * 512 + hh * 128 + 2 * pp) = cvtpk(kk0[u], kk1[u]);
            }
            kt0[e >> 1] = cvtpk(kk0[0], kk0[1]); kt1[e >> 1] = cvtpk(kk1[0], kk1[1]);
        }
        bf16* ktt = KTT + ((size_t)(cg * 4 + hh) * 128) * 64 + 8 * tg;
        *(v4u*)(ktt + (size_t)(2 * pp) * 64) = (v4u){kt0[0], kt0[1], kt0[2], kt0[3]};
        *(v4u*)(ktt + (size_t)(2 * pp + 1) * 64) = (v4u){kt1[0], kt1[1], kt1[2], kt1[3]};
    }
}

namespace gl {
constexpr int QT_OFF = 0, QT_STR = 272;
constexpr int KT_OFF = 17408;
constexpr int P_OFF = 34816, P_STR = 144;
constexpr int ST_OFF = 44032, ST_STR = 272;
constexpr int KTT_OFF = 61440, KTT_STR = 144;
constexpr int VT_OFF = 98304, VT_STR = 144;
constexpr int GV_OFF = 116736;
constexpr int NSTEP = 68;
}
__device__ __forceinline__ bf16x8 lds_frag(LAS unsigned char* lds, int off) { return *(const LAS bf16x8*)(lds + off); }
__device__ __forceinline__ void p3b_scan(KArgs* ap, LAS unsigned char* lds, int unit, int tid) {
    using namespace gl;
    unsigned char* ws = ap->ws;
    const int vs = unit & 3, dir = (unit >> 2) & 1, hh = (unit >> 3) & 3, b = unit >> 5;
    const bf16* QT = (const bf16*)(ws + WS_QT0 + dir * WS_DIR1); const bf16* KT = (const bf16*)(ws + WS_KT0 + dir * WS_DIR1); const bf16* KTT = (const bf16*)(ws + WS_KTT0 + dir * WS_DIR1);
    const bf16* V = (const bf16*)(ws + WS_V); const float* GG = (const float*)((const unsigned char*)ap->out + OUT_G) + (size_t)dir * NCHUNK * 512;
    bf16* O = (bf16*)(ws + (dir ? WS_OB : WS_OF));
    const int lane = tid & 63, wave = __builtin_amdgcn_readfirstlane(tid >> 6), r32 = lane & 31, h = lane >> 5;
    for (int i = tid; i < 64 * ST_STR / 4; i += 512) ((LAS unsigned*)(lds + ST_OFF))[i] = 0u;
    f32x16 Sacc;
#pragma unroll
    for (int i = 0; i < 16; ++i) Sacc[i] = 0.f;
    v4u rq[2], rk[2], rt[2], rv; f32x4 rg = (f32x4){0.f, 0.f, 0.f, 0.f};
#define GLA_CG(st) ((st) < 4 ? (MX / 64 + b * 4 + (dir ? 3 - (st) : (st))) : (b * 64 + (dir ? 63 - ((st) - 4) : ((st) - 4))))
#define GLA_LOADS(st) do { const int cg_ = GLA_CG(st); const size_t base_ = (size_t)cg_ * 64; \
        _Pragma("unroll") for (int i_ = 0; i_ < 2; ++i_) { const int id_ = tid + 512 * i_; \
            rk[i_] = *(const v4u*)(KT + (base_ + (id_ >> 4)) * 512 + hh * 128 + (id_ & 15) * 8); \
            rq[i_] = (st) >= 4 ? *(const v4u*)(QT + (base_ + (id_ >> 4)) * 512 + hh * 128 + (id_ & 15) * 8) : (v4u){0u, 0u, 0u, 0u}; \
            rt[i_] = *(const v4u*)(KTT + ((size_t)(cg_ * 4 + hh) * 128 + (id_ >> 3)) * 64 + (id_ & 7) * 8); } \
        rv = *(const v4u*)(V + (base_ + (tid & 63)) * 1024 + hh * 256 + vs * 64 + (tid >> 6) * 8); \
        if (tid < 32) rg = *(const f32x4*)(GG + ((size_t)cg_ * 4 + hh) * 128 + tid * 4); } while (0)
#define GLA_FILL(bf) do { \
        _Pragma("unroll") for (int i_ = 0; i_ < 2; ++i_) { const int id_ = tid + 512 * i_; \
            *(LAS v4u*)(lds + QT_OFF + (id_ >> 4) * QT_STR + (id_ & 15) * 16) = rq[i_]; *(LAS v4u*)(lds + KT_OFF + (id_ >> 4) * QT_STR + (id_ & 15) * 16) = rk[i_]; \
            *(LAS v4u*)(lds + KTT_OFF + (bf) * 18432 + (id_ >> 3) * KTT_STR + (id_ & 7) * 16) = rt[i_]; } \
        { LAS unsigned short* vt = (LAS unsigned short*)(lds + VT_OFF + (bf) * 9216 + ((tid >> 6) * 8) * VT_STR + 2 * (tid & 63)); \
          vt[0 * (VT_STR / 2)] = (unsigned short)(rv.x & 0xffffu); vt[1 * (VT_STR / 2)] = (unsigned short)(rv.x >> 16); \
          vt[2 * (VT_STR / 2)] = (unsigned short)(rv.y & 0xffffu); vt[3 * (VT_STR / 2)] = (unsigned short)(rv.y >> 16); \
          vt[4 * (VT_STR / 2)] = (unsigned short)(rv.z & 0xffffu); vt[5 * (VT_STR / 2)] = (unsigned short)(rv.z >> 16); \
          vt[6 * (VT_STR / 2)] = (unsigned short)(rv.w & 0xffffu); vt[7 * (VT_STR / 2)] = (unsigned short)(rv.w >> 16); } \
        if (tid < 32) *(LAS f32x4*)(lds + GV_OFF + (bf) * 512 + tid * 16) = rg; } while (0)
    GLA_LOADS(0);
    GLA_FILL(0);
    GLA_LOADS(1);
    __syncthreads();
    const int w4 = wave & 3, it = w4 >> 1, vt_ = w4 & 1;
    for (int st = 0; st < NSTEP; ++st) {
        const bool lat = st >= 4; const int buf = st & 1;
        f32x16 oacc;
#pragma unroll
        for (int i = 0; i < 16; ++i) oacc[i] = 0.f;
        if (lat) {
            if (wave < 4) {
                const int jt = it, it2 = vt_;
                f32x16 pacc;
#pragma unroll
                for (int i = 0; i < 16; ++i) pacc[i] = 0.f;
#pragma unroll
                for (int s = 0; s < 8; ++s) {
                    const bf16x8 a = lds_frag(lds, KT_OFF + (32 * jt + r32) * QT_STR + 32 * s + 16 * h);
                    const bf16x8 bq = lds_frag(lds, QT_OFF + (32 * it2 + r32) * QT_STR + 32 * s + 16 * h);
                    pacc = __builtin_amdgcn_mfma_f32_32x32x16_bf16(a, bq, pacc, 0, 0, 0);
                }
                const int i = 32 * it2 + r32;
#pragma unroll
                for (int g = 0; g < 4; ++g) {
                    float pv[4];
#pragma unroll
                    for (int u = 0; u < 4; ++u) { const int j = 32 * jt + 8 * g + 4 * h + u; const bool keep = dir == 0 ? (j <= i) : (j >= i); pv[u] = keep ? pacc[4 * g + u] : 0.f; }
                    *(LAS v2u*)(lds + P_OFF + i * P_STR + 2 * (32 * jt + 8 * g + 4 * h)) = (v2u){cvtpk(pv[0], pv[1]), cvtpk(pv[2], pv[3])};
                }
            } else {
#pragma unroll
                for (int s = 0; s < 8; ++s) {
                    const bf16x8 a = lds_frag(lds, QT_OFF + (32 * it + r32) * QT_STR + 32 * s + 16 * h);
                    const bf16x8 bs = lds_frag(lds, ST_OFF + (32 * vt_ + r32) * ST_STR + 32 * s + 16 * h);
                    oacc = __builtin_amdgcn_mfma_f32_32x32x16_bf16(a, bs, oacc, 0, 0, 0);
                }
            }
        }
        __syncthreads();
        if (lat && wave >= 4) {
#pragma unroll
            for (int s = 0; s < 4; ++s) {
                const bf16x8 a = lds_frag(lds, P_OFF + (32 * it + r32) * P_STR + 32 * s + 16 * h);
                const bf16x8 bv = lds_frag(lds, VT_OFF + buf * 9216 + (32 * vt_ + r32) * VT_STR + 32 * s + 16 * h);
                oacc = __builtin_amdgcn_mfma_f32_32x32x16_bf16(a, bv, oacc, 0, 0, 0);
            }
            bf16* op = O + (size_t)GLA_CG(st) * 64 * 1024 + hh * 256 + vs * 64 + 32 * vt_ + r32;
#pragma unroll
            for (int rg_ = 0; rg_ < 16; ++rg_) { const int i = 32 * it + (rg_ & 3) + 8 * (rg_ >> 2) + 4 * h; op[(size_t)i * 1024] = (bf16)(cvtpk(oacc[rg_], 0.f) & 0xffffu); }
        }
        {
            const int dt = wave >> 1, vt2 = wave & 1;
#pragma unroll
            for (int s = 0; s < 4; ++s) {
                const bf16x8 a = lds_frag(lds, KTT_OFF + buf * 18432 + (32 * dt + r32) * KTT_STR + 32 * s + 16 * h);
                const bf16x8 bv = lds_frag(lds, VT_OFF + buf * 9216 + (32 * vt2 + r32) * VT_STR + 32 * s + 16 * h);
                Sacc = __builtin_amdgcn_mfma_f32_32x32x16_bf16(a, bv, Sacc, 0, 0, 0);
            }
#pragma unroll
            for (int g = 0; g < 4; ++g) {
                const f32x4 gv = *(const LAS f32x4*)(lds + GV_OFF + buf * 512 + (32 * dt + 8 * g + 4 * h) * 4);
                Sacc[4 * g] *= gv[0]; Sacc[4 * g + 1] *= gv[1]; Sacc[4 * g + 2] *= gv[2]; Sacc[4 * g + 3] *= gv[3];
                *(LAS v2u*)(lds + ST_OFF + (32 * vt2 + r32) * ST_STR + 2 * (32 * dt + 8 * g + 4 * h)) = (v2u){cvtpk(Sacc[4 * g], Sacc[4 * g + 1]), cvtpk(Sacc[4 * g + 2], Sacc[4 * g + 3])};
            }
        }
        if (st + 1 < NSTEP) { GLA_FILL(buf ^ 1); if (st + 2 < NSTEP) GLA_LOADS(st + 2); }
        __syncthreads();
    }
#undef GLA_CG
#undef GLA_LOADS
#undef GLA_FILL
}

__device__ __forceinline__ void p4_stats(KArgs* ap, int vcu, int G, int lane, int wave) {
    const bf16* OF = (const bf16*)(ap->ws + WS_OF); const bf16* OB = (const bf16*)(ap->ws + WS_OB); float* RS = (float*)(ap->ws + WS_RSTD);
    const int gw = vcu * NWAVES + wave, NGW = G * NWAVES;
    for (int m0 = gw; m0 < MX; m0 += 4 * NGW) {
        v4u f[4][2], g[4][2];
#pragma unroll
        for (int q = 0; q < 4; ++q) { const int m = m0 + q * NGW; const size_t off = (size_t)(m < MX ? m : gw) * 1024 + lane * 16;
            f[q][0] = *(const v4u*)(OF + off); f[q][1] = *(const v4u*)(OF + off + 8); g[q][0] = *(const v4u*)(OB + off); g[q][1] = *(const v4u*)(OB + off + 8); }
#pragma unroll
        for (int q = 0; q < 4; ++q) { const int m = m0 + q * NGW;
            float s = 0.f;
#pragma unroll
            for (int j = 0; j < 2; ++j) { const v4u ff = f[q][j], gg = g[q][j]; float o;
                o = bflo(ff.x) + bflo(gg.x); s += o * o; o = bfhi(ff.x) + bfhi(gg.x); s += o * o; o = bflo(ff.y) + bflo(gg.y); s += o * o; o = bfhi(ff.y) + bfhi(gg.y); s += o * o;
                o = bflo(ff.z) + bflo(gg.z); s += o * o; o = bfhi(ff.z) + bfhi(gg.z); s += o * o; o = bflo(ff.w) + bflo(gg.w); s += o * o; o = bfhi(ff.w) + bfhi(gg.w); s += o * o; }
            s += __shfl_xor(s, 1); s += __shfl_xor(s, 2); s += __shfl_xor(s, 4); s += __shfl_xor(s, 8);
            if ((lane & 15) == 0 && m < MX) RS[(size_t)m * 4 + (lane >> 4)] = 1.0f / sqrtf(s * (1.0f / 256.0f) + EPS); }
    }
}

__device__ __forceinline__ void unpack8(const v4u u, float (&f)[8]) { f[0] = bflo(u.x); f[1] = bfhi(u.x); f[2] = bflo(u.y); f[3] = bfhi(u.y); f[4] = bflo(u.z); f[5] = bfhi(u.z); f[6] = bflo(u.w); f[7] = bfhi(u.w); }
template <int W> __device__ __forceinline__ void pool_item(const bf16* UB, bf16* D, int rb, int ch) {
    constexpr int HALF = W / 2, R = 8 + W - 1;
    const int row0 = rb * 8, s0 = row0 & (SEQ - 1), base = row0 - s0;
    v4u u[R];
#pragma unroll
    for (int r = 0; r < R; ++r) { const int t = s0 - HALF + r; u[r] = (t >= 0 && t < SEQ) ? *(const v4u*)(UB + (size_t)(base + t) * 1024 + ch * 8) : (v4u){0u, 0u, 0u, 0u}; }
    float S[8];
#pragma unroll
    for (int e = 0; e < 8; ++e) S[e] = 0.f;
#pragma unroll
    for (int r = 0; r < W; ++r) { float f[8]; unpack8(u[r], f);
#pragma unroll
        for (int e = 0; e < 8; ++e) S[e] += f[e]; }
#pragma unroll
    for (int i = 0; i < 8; ++i) {
        const int sq = s0 + i; int lo = sq - HALF, hi = sq + (W - 1 - HALF); lo = lo < 0 ? 0 : lo; hi = hi > SEQ - 1 ? SEQ - 1 : hi;
        const float inv = 1.0f / (float)(hi - lo + 1);
        float c[8]; unpack8(u[i + HALF], c);
        v4u o;
        o.x = cvtpk(S[0] * inv - c[0], S[1] * inv - c[1]); o.y = cvtpk(S[2] * inv - c[2], S[3] * inv - c[3]);
        o.z = cvtpk(S[4] * inv - c[4], S[5] * inv - c[5]); o.w = cvtpk(S[6] * inv - c[6], S[7] * inv - c[7]);
        *(v4u*)(D + (size_t)(row0 + i) * 1024 + ch * 8) = o;
        if (i < 7) { float p[8], q[8]; unpack8(u[i + W], p); unpack8(u[i], q);
#pragma unroll
            for (int e = 0; e < 8; ++e) S[e] += p[e] - q[e]; }
    }
}
__device__ __forceinline__ void p6_pool(KArgs* ap, int vcu, int G, int tid) {
    const bf16* UB = (const bf16*)(ap->ws + WS_UB); bf16* D = (bf16*)(ap->ws + WS_D);
    const int gt = vcu * 512 + tid, NT = G * 512;
    for (int idx = gt; idx < (MX / 8) * 128; idx += NT) {
        const int g = (idx >> 6) & 3, ch = 32 * g + (idx & 31), rb = ((idx >> 8) << 1) | ((idx >> 5) & 1);
        if (g == 0) pool_item<2>(UB, D, rb, ch); else if (g == 1) pool_item<4>(UB, D, rb, ch); else if (g == 2) pool_item<8>(UB, D, rb, ch); else pool_item<16>(UB, D, rb, ch);
    }
}

__device__ __forceinline__ void p11_final(KArgs* ap, int vcu, int G, int lane, int wave) {
    const float* SS = (const float*)(ap->ws + WS_SS); const float* fg = ap->in[18];
    const int gw = vcu * NWAVES + wave, NGW = G * NWAVES;
    f32x4 g[4];
#pragma unroll
    for (int j = 0; j < 4; ++j) g[j] = *(const f32x4*)(fg + 4 * lane + 256 * j);
    for (int m0 = gw; m0 < MX; m0 += 2 * NGW) {
        f32x4 v[2][4]; float s[2];
#pragma unroll
        for (int q = 0; q < 2; ++q) { const int m = (m0 + q * NGW) < MX ? (m0 + q * NGW) : m0; s[q] = lane < 16 ? SS[(size_t)m * 16 + lane] : 0.f; const float* o = ap->out + (size_t)m * DM + 4 * lane;
#pragma unroll
            for (int j = 0; j < 4; ++j) v[q][j] = *(const f32x4*)(o + 256 * j); }
#pragma unroll
        for (int q = 0; q < 2; ++q) { const int m = m0 + q * NGW; if (m >= MX) break;
            float t = s[q]; t += __shfl_xor(t, 1); t += __shfl_xor(t, 2); t += __shfl_xor(t, 4); t += __shfl_xor(t, 8); t = __shfl(t, 0);
            const float rstd = 1.0f / sqrtf(t * (1.0f / DM) + EPS);
            float* o = ap->out + (size_t)m * DM + 4 * lane;
#pragma unroll
            for (int j = 0; j < 4; ++j) *(f32x4*)(o + 256 * j) = v[q][j] * rstd * g[j]; }
    }
}

constexpr int NPHASE = 12;
__global__ void __launch_bounds__(NWAVES * 64, 2) fwd_kernel(Args args) {
    extern __shared__ __attribute__((aligned(16))) unsigned char lds_raw[];
    LAS unsigned char* lds = (LAS unsigned char*)lds_raw;
    {
        const int tid = threadIdx.x;
        for (int u = tid; u < (LDS_BYTES - LDSCTL_OFF) / 4; u += NWAVES * 64) ((LAS unsigned*)(lds + LDSCTL_OFF))[u] = 0u;
        __syncthreads();
    }
    const int lo = args.ph_lo, hi = args.ph_hi;
    XcdBarrier bar; bar.bar = (unsigned*)(args.ws + WS_CTL) + CW_BAR; bar.x = 0; bar.st = nullptr;
    if (hi - lo > 1) bar = xcd_barrier_post((unsigned*)(args.ws + WS_CTL) + CW_BAR, (volatile LAS unsigned*)(lds + MISC_OFF) + 8);
#define IN(k) (lo <= (k) && (k) < hi)
#define SEAM(k) do { if ((k) + 1 < hi) xcd_barrier(bar); } while (0)
#define PH_VARS KArgs* ap = kargs(); unsigned char* ws = ap->ws; const int tid = threadIdx.x, lane = tid & 63, wave = __builtin_amdgcn_readfirstlane(tid >> 6); \
    const int G = gridDim.x, bx = blockIdx.x, vcu = (G % 8 == 0) ? (bx % 8) * (G / 8) + bx / 8 : bx; (void)ws; (void)lane; (void)wave; (void)vcu; (void)tid;

    if (IN(0)) { PH_VARS p0_prep(ap, lds, vcu, G, tid, lane, wave); SEAM(0); }
    if (IN(1)) { PH_VARS p1_rows(ap, (bf16*)ap->out, vcu, G, lane, wave); SEAM(1); }
    if (IN(2)) { PH_VARS
        pg8::Gemm g{(const bf16*)ap->out, (const bf16*)(ws + WS_W1T), 1024, 1024, 0}; OrderG1A S; S.init(G, bx);
        EpiQKV E{(bf16*)(ws + WS_Q), (bf16*)(ws + WS_K), (bf16*)(ws + WS_V), (float*)(ws + WS_LR), (const float*)(ws + WS_ROPE)};
        pg8::gemm_phase<EpiQKV, OrderG1A, true, true>(lds, g, S, E);
        SEAM(2);
    }
#ifdef GLA_NAIVE
    if (IN(3)) { PH_VARS if (vcu < 64) p3_gla_naive(ap, lds, vcu, tid); SEAM(3); }
#else
    if (IN(3)) { PH_VARS p3a_decay(ap, lds, vcu, G, tid); xcd_barrier(bar); p3b_scan(ap, lds, vcu, tid); SEAM(3); }
#endif
    if (IN(4)) { PH_VARS p4_stats(ap, vcu, G, lane, wave); SEAM(4); }
    if (IN(5)) { PH_VARS
        pg8::Gemm g{(const bf16*)ap->out, (const bf16*)(ws + WS_W1T) + (size_t)N1A * 1024, 1024, 1024, 0}; pg8::StaticOrder S; S.init(MX, N1 - N1A, G, bx);
        EpiB E{(bf16*)(ws + WS_A1), (bf16*)(ws + WS_UB), (bf16*)(ws + WS_ZB), (bf16*)(ws + WS_GA), (bf16*)(ws + WS_GB), (const bf16*)(ws + WS_OF), (const bf16*)(ws + WS_OB), (const float*)(ws + WS_RSTD), ap->in[12]};
        pg8::gemm_phase<EpiB, pg8::StaticOrder, true, true>(lds, g, S, E);
        SEAM(5);
    }
    if (IN(6)) { PH_VARS p6_pool(ap, vcu, G, tid); SEAM(6); }
    if (IN(7)) { PH_VARS
        pg8::Gemm g{(const bf16*)(ws + WS_D), (const bf16*)(ws + WS_WPT), 256, 1024, 256}; pg8::StaticOrder S; S.init(MX, 1024, G, bx);
        EpiMul<0> E{(bf16*)(ws + WS_ZB), nullptr, ap->in[14]};
        pg8::gemm_phase<EpiMul<0>, pg8::StaticOrder, true, true>(lds, g, S, E);
        SEAM(7);
    }
    if (IN(8)) { PH_VARS
        pg8::Gemm g{(const bf16*)(ws + WS_A1), (const bf16*)(ws + WS_WAT), 1024, 1024, 0}; pg8::StaticOrder S; S.init(MX, 1024, G, bx);
        EpiMul<1> E{(bf16*)(ws + WS_GA), nullptr, nullptr};
        pg8::gemm_phase<EpiMul<1>, pg8::StaticOrder, true, true>(lds, g, S, E);
        SEAM(8);
    }
    if (IN(9)) { PH_VARS
        pg8::Gemm g{(const bf16*)(ws + WS_ZB), (const bf16*)(ws + WS_WBT), 1024, 1024, 0}; pg8::StaticOrder S; S.init(MX, 1024, G, bx);
        EpiMul<2> E{(bf16*)(ws + WS_GB), (const bf16*)(ws + WS_GA), nullptr};
        pg8::gemm_phase<EpiMul<2>, pg8::StaticOrder, true, true>(lds, g, S, E);
        SEAM(9);
    }
    if (IN(10)) { PH_VARS
        pg8::Gemm g{(const bf16*)(ws + WS_GB), (const bf16*)(ws + WS_WOT), 1024, 1024, 0}; pg8::StaticOrder S; S.init(MX, 1024, G, bx);
        EpiOut E{ap->in[0], ap->out, (const float*)(ws + WS_MOD), (float*)(ws + WS_SS)};
        pg8::gemm_phase<EpiOut, pg8::StaticOrder, true, true>(lds, g, S, E);
        SEAM(10);
    }
    if (IN(11)) { PH_VARS p11_final(ap, vcu, G, lane, wave); }
#undef IN
#undef SEAM
}

#ifndef MK_ONE_LAUNCH
#define MK_ONE_LAUNCH 1
#endif
extern "C" void kernel_launch(void* const* d_in, const int* in_sizes, int n_in, void* d_out, int out_size, void* d_ws, size_t ws_size, hipStream_t stream) {
    static int grid = 0;
    if (grid == 0) {
        if (n_in != 19 || in_sizes[0] != MX * DM || out_size != MX * DM || ws_size < WS_END) { fprintf(stderr, "kernel_launch: unexpected shapes (n_in %d, in0 %d, out %d, ws %zu); nothing launched\n", n_in, n_in > 0 ? in_sizes[0] : -1, out_size, ws_size); grid = -1; return; }
        int dev = 0, cus = 0, per_cu = 0;
        if (hipGetDevice(&dev) != hipSuccess || hipDeviceGetAttribute(&cus, hipDeviceAttributeMultiprocessorCount, dev) != hipSuccess) { grid = -1; return; }
        if (hipFuncSetAttribute((const void*)fwd_kernel, hipFuncAttributeMaxDynamicSharedMemorySize, LDS_BYTES) != hipSuccess) { fprintf(stderr, "kernel_launch: hipFuncSetAttribute failed\n"); grid = -1; return; }
        if (hipOccupancyMaxActiveBlocksPerMultiprocessor(&per_cu, (const void*)fwd_kernel, NWAVES * 64, LDS_BYTES) != hipSuccess || per_cu < 1) fprintf(stderr, "kernel_launch: occupancy query reports %d workgroups per CU\n", per_cu);
        (void)hipGetLastError();
        grid = cus;
    }
    if (grid < 0) return;
    if (hipMemsetAsync((char*)d_ws + WS_CTL, 0, CTL_ZERO_BYTES, stream) != hipSuccess) { fprintf(stderr, "kernel_launch: memset failed\n"); return; }
    Args a{};
    for (int i = 0; i < 19; ++i) a.in[i] = (const float*)d_in[i];
    a.out = (float*)d_out; a.ws = (unsigned char*)d_ws;
#if MK_ONE_LAUNCH
    a.ph_lo = 0; a.ph_hi = NPHASE;
    hipLaunchKernelGGL(fwd_kernel, dim3(grid), dim3(NWAVES * 64), LDS_BYTES, stream, a);
#else
    for (int p = 0; p < NPHASE; ++p) { a.ph_lo = p; a.ph_hi = p + 1; hipLaunchKernelGGL(fwd_kernel, dim3(grid), dim3(NWAVES * 64), LDS_BYTES, stream, a); }
#endif
    const hipError_t le = hipPeekAtLastError();
    if (le != hipSuccess) fprintf(stderr, "kernel_launch: launch failed: %s\n", hipGetErrorName(le));
}
```
